# Optimizing an MI355X kernel written in HIP

```python
import jax, jax.numpy as jnp
from jax import lax
import numpy as np

D_MODEL = 1024
BATCH = 4
SEQ = 8192
DEPTH = 4

N_META = 16
BLOCK_Q = 128
N_MIXERS = 2
EPS = 1e-6
FOX_HEADS = 16
FOX_HEAD_DIM = D_MODEL // FOX_HEADS
FOX_TAU_MIN = 4.0
FOX_TAU_MAX = 4096.0
MLA_HEADS = 16
MLA_NOPE_DIM = 64
MLA_ROPE_DIM = 32
MLA_V_DIM = 64
MLA_Q_RANK = D_MODEL // 4
MLA_KV_RANK = D_MODEL // 8
ROPE_THETA = 10000.0
D_FF = 2816
N_EXPERTS = 8
TOP_K = 2
MAX_POS_OFFSET = 1024

kernel_name = 'hybrid_fox_mla_moe_meta_trunk'


def rms_norm(x, g):
    xf = x.astype(jnp.float32)
    y = xf * lax.rsqrt(jnp.mean(xf * xf, axis=-1, keepdims=True) + EPS)
    return (y * g.astype(jnp.float32)).astype(x.dtype)


def rope_angles(pos):
    inv_freq = ROPE_THETA ** (-jnp.arange(0, MLA_ROPE_DIM, 2, dtype=jnp.float32) / MLA_ROPE_DIM)
    return pos.astype(jnp.float32)[..., None] * inv_freq


def rotary(x, angles):
    half = x.shape[-1] // 2
    xf = x.astype(jnp.float32)
    x1, x2 = xf[..., :half], xf[..., half:]
    cos, sin = jnp.cos(angles), jnp.sin(angles)
    return jnp.concatenate([x1 * cos - x2 * sin, x2 * cos + x1 * sin], axis=-1).astype(x.dtype)


def causal_block_attention(q, k, v, decay):
    B, H, L, dk = q.shape
    dv = v.shape[-1]
    scale = dk ** -0.5
    n_real = L - N_META
    n_blocks = n_real // BLOCK_Q

    def attend(q_blk, q_pos, k_, v_, c_q, c_k):
        s = jnp.einsum('bhqd,bhkd->bhqk', q_blk, k_).astype(jnp.float32) * scale
        if c_q is not None:
            s = s + c_q[..., :, None] - c_k[..., None, :]
        mask = q_pos[:, None] >= jnp.arange(k_.shape[2])[None, :]
        p = jax.nn.softmax(jnp.where(mask, s, -jnp.inf), axis=-1)
        return jnp.einsum('bhqk,bhkd->bhqd', p.astype(v_.dtype), v_)

    def to_blocks(a):
        a = a[:, :, N_META:]
        a = a.reshape(a.shape[:2] + (n_blocks, BLOCK_Q) + a.shape[3:])
        return jnp.moveaxis(a, 2, 0)

    meta_pos = jnp.arange(N_META)
    c_meta = None if decay is None else decay[:, :, :N_META]
    out_meta = attend(q[:, :, :N_META], meta_pos, k[:, :, :N_META], v[:, :, :N_META], c_meta, c_meta)

    q_blocks = to_blocks(q)
    pos_blocks = N_META + jnp.arange(n_real).reshape(n_blocks, BLOCK_Q)
    if decay is None:
        out = lax.map(lambda xs: attend(xs[0], xs[1], k, v, None, None), (q_blocks, pos_blocks))
    else:
        c_blocks = to_blocks(decay)
        out = lax.map(lambda xs: attend(xs[0], xs[1], k, v, xs[2], decay), (q_blocks, pos_blocks, c_blocks))
    out = jnp.moveaxis(out, 0, 2).reshape(B, H, n_real, dv)
    return jnp.concatenate([out_meta, out], axis=2)


def fox_mixer(h, mix_norm, w_in, b_f, q_norm, k_norm, w_out):
    B, L, _ = h.shape
    xn = rms_norm(h, mix_norm)
    proj = xn @ w_in
    q, k, v, gate = jnp.split(proj[..., :4 * D_MODEL], 4, axis=-1)
    f_logit = (proj[..., 4 * D_MODEL:] + b_f).astype(jnp.float32)
    heads = lambda a: a.reshape(B, L, FOX_HEADS, FOX_HEAD_DIM)
    q = rms_norm(heads(q), q_norm).transpose(0, 2, 1, 3)
    k = rms_norm(heads(k), k_norm).transpose(0, 2, 1, 3)
    v = heads(v).transpose(0, 2, 1, 3)
    decay = jnp.cumsum(jax.nn.log_sigmoid(f_logit), axis=1).transpose(0, 2, 1)
    o = causal_block_attention(q, k, v, decay)
    o = o.transpose(0, 2, 1, 3).reshape(B, L, D_MODEL) * jax.nn.sigmoid(gate)
    return o @ w_out


def mla_mixer(h, angles, mix_norm, w_in, q_a_norm, w_q_up, kv_a_norm, w_kv_up,
              q_norm, k_nope_norm, k_rope_norm, w_out):
    B, L, _ = h.shape
    xn = rms_norm(h, mix_norm)
    proj = xn @ w_in
    c_q = rms_norm(proj[..., :MLA_Q_RANK], q_a_norm)
    c_kv = rms_norm(proj[..., MLA_Q_RANK:MLA_Q_RANK + MLA_KV_RANK], kv_a_norm)
    k_rope = proj[..., MLA_Q_RANK + MLA_KV_RANK:]

    q = (c_q @ w_q_up).reshape(B, L, MLA_HEADS, MLA_NOPE_DIM + MLA_ROPE_DIM)
    q = rms_norm(q, q_norm)
    q = jnp.concatenate([q[..., :MLA_NOPE_DIM], rotary(q[..., MLA_NOPE_DIM:], angles[:, :, None, :])], axis=-1)

    kv = (c_kv @ w_kv_up).reshape(B, L, MLA_HEADS, MLA_NOPE_DIM + MLA_V_DIM)
    k_nope = rms_norm(kv[..., :MLA_NOPE_DIM], k_nope_norm)
    v = kv[..., MLA_NOPE_DIM:]
    k_rope = rotary(rms_norm(k_rope, k_rope_norm), angles)
    k = jnp.concatenate([k_nope, jnp.broadcast_to(k_rope[:, :, None, :], (B, L, MLA_HEADS, MLA_ROPE_DIM))], axis=-1)

    o = causal_block_attention(q.transpose(0, 2, 1, 3), k.transpose(0, 2, 1, 3), v.transpose(0, 2, 1, 3), None)
    o = o.transpose(0, 2, 1, 3).reshape(B, L, MLA_HEADS * MLA_V_DIM)
    return o @ w_out


def dense_swiglu(h, ffn_norm, w_in, w_out):
    xn = rms_norm(h, ffn_norm)
    g, u = jnp.split(xn @ w_in, 2, axis=-1)
    return (jax.nn.silu(g) * u) @ w_out


def moe_swiglu(h, ffn_norm, w_router, w_in, w_out):
    xn = rms_norm(h, ffn_norm)
    logits = (xn @ w_router).astype(jnp.float32)
    top_vals, top_idx = lax.top_k(logits, TOP_K)
    top_w = jax.nn.softmax(top_vals, axis=-1)
    combine = jnp.sum(jax.nn.one_hot(top_idx, N_EXPERTS, dtype=jnp.float32) * top_w[..., None], axis=-2)
    combine = combine.astype(h.dtype)
    y = jnp.zeros_like(h)
    for e in range(N_EXPERTS):
        g, u = jnp.split(xn @ w_in[e], 2, axis=-1)
        y = y + combine[..., e:e + 1] * ((jax.nn.silu(g) * u) @ w_out[e])
    return y


def setup_inputs(seed: int = 0) -> dict:
    key = jax.random.key(seed)
    ks = iter(jax.random.split(key, 128))
    nk = lambda: next(ks)
    dense = lambda shape, fan_in: jax.random.normal(nk(), shape, jnp.float32) * fan_in ** -0.5
    gain = lambda n: 1.0 + 0.02 * jax.random.normal(nk(), (n,), jnp.float32)

    inp = {}
    inp['x'] = jax.random.normal(nk(), (BATCH, SEQ, D_MODEL), jnp.float32)
    offset = jax.random.randint(nk(), (BATCH, 1), 0, MAX_POS_OFFSET, dtype=jnp.int32)
    inp['positions'] = (N_META + offset + jnp.arange(SEQ, dtype=jnp.int32)[None, :]).astype(jnp.int32)
    inp['meta_tokens'] = jax.random.normal(nk(), (N_META, D_MODEL), jnp.float32)

    tau = jnp.geomspace(FOX_TAU_MIN, FOX_TAU_MAX, FOX_HEADS).astype(jnp.float32)
    for i in range(DEPTH):
        p = 'l%d_' % i
        inp[p + 'mix_norm'] = gain(D_MODEL)
        if i % N_MIXERS == 0:
            inp[p + 'fox_w_in'] = dense((D_MODEL, 4 * D_MODEL + FOX_HEADS), D_MODEL)
            inp[p + 'fox_b_f'] = jnp.log(tau - 1.0) + 0.01 * jax.random.normal(nk(), (FOX_HEADS,), jnp.float32)
            inp[p + 'fox_q_norm'] = gain(FOX_HEAD_DIM)
            inp[p + 'fox_k_norm'] = gain(FOX_HEAD_DIM)
            inp[p + 'fox_w_out'] = dense((D_MODEL, D_MODEL), D_MODEL)
        else:
            inp[p + 'mla_w_in'] = dense((D_MODEL, MLA_Q_RANK + MLA_KV_RANK + MLA_ROPE_DIM), D_MODEL)
            inp[p + 'mla_q_a_norm'] = gain(MLA_Q_RANK)
            inp[p + 'mla_w_q_up'] = dense((MLA_Q_RANK, MLA_HEADS * (MLA_NOPE_DIM + MLA_ROPE_DIM)), MLA_Q_RANK)
            inp[p + 'mla_kv_a_norm'] = gain(MLA_KV_RANK)
            inp[p + 'mla_w_kv_up'] = dense((MLA_KV_RANK, MLA_HEADS * (MLA_NOPE_DIM + MLA_V_DIM)), MLA_KV_RANK)
            inp[p + 'mla_q_norm'] = gain(MLA_NOPE_DIM + MLA_ROPE_DIM)
            inp[p + 'mla_k_nope_norm'] = gain(MLA_NOPE_DIM)
            inp[p + 'mla_k_rope_norm'] = gain(MLA_ROPE_DIM)
            inp[p + 'mla_w_out'] = dense((MLA_HEADS * MLA_V_DIM, D_MODEL), MLA_HEADS * MLA_V_DIM)
        inp[p + 'ffn_norm'] = gain(D_MODEL)
        if i % 2 == 0:
            inp[p + 'ffn_w_in'] = dense((D_MODEL, 2 * D_FF), D_MODEL)
            inp[p + 'ffn_w_out'] = dense((D_FF, D_MODEL), D_FF)
        else:
            inp[p + 'moe_w_router'] = dense((D_MODEL, N_EXPERTS), D_MODEL)
            inp[p + 'moe_w_in'] = dense((N_EXPERTS, D_MODEL, 2 * D_FF), D_MODEL)
            inp[p + 'moe_w_out'] = dense((N_EXPERTS, D_FF, D_MODEL), D_FF)
    return inp


def reference(x, positions, meta_tokens,
              l0_mix_norm, l0_fox_w_in, l0_fox_b_f, l0_fox_q_norm, l0_fox_k_norm, l0_fox_w_out,
              l0_ffn_norm, l0_ffn_w_in, l0_ffn_w_out,
              l1_mix_norm, l1_mla_w_in, l1_mla_q_a_norm, l1_mla_w_q_up, l1_mla_kv_a_norm, l1_mla_w_kv_up,
              l1_mla_q_norm, l1_mla_k_nope_norm, l1_mla_k_rope_norm, l1_mla_w_out,
              l1_ffn_norm, l1_moe_w_router, l1_moe_w_in, l1_moe_w_out,
              l2_mix_norm, l2_fox_w_in, l2_fox_b_f, l2_fox_q_norm, l2_fox_k_norm, l2_fox_w_out,
              l2_ffn_norm, l2_ffn_w_in, l2_ffn_w_out,
              l3_mix_norm, l3_mla_w_in, l3_mla_q_a_norm, l3_mla_w_q_up, l3_mla_kv_a_norm, l3_mla_w_kv_up,
              l3_mla_q_norm, l3_mla_k_nope_norm, l3_mla_k_rope_norm, l3_mla_w_out,
              l3_ffn_norm, l3_moe_w_router, l3_moe_w_in, l3_moe_w_out):
    B = x.shape[0]
    h = jnp.concatenate([jnp.broadcast_to(meta_tokens.astype(x.dtype)[None], (B, N_META, D_MODEL)), x], axis=1)
    pos = jnp.concatenate([jnp.broadcast_to(jnp.arange(N_META, dtype=positions.dtype)[None], (B, N_META)), positions], axis=1)
    angles = rope_angles(pos)

    mixer_params = [
        (l0_mix_norm, l0_fox_w_in, l0_fox_b_f, l0_fox_q_norm, l0_fox_k_norm, l0_fox_w_out),
        (l1_mix_norm, l1_mla_w_in, l1_mla_q_a_norm, l1_mla_w_q_up, l1_mla_kv_a_norm, l1_mla_w_kv_up,
         l1_mla_q_norm, l1_mla_k_nope_norm, l1_mla_k_rope_norm, l1_mla_w_out),
        (l2_mix_norm, l2_fox_w_in, l2_fox_b_f, l2_fox_q_norm, l2_fox_k_norm, l2_fox_w_out),
        (l3_mix_norm, l3_mla_w_in, l3_mla_q_a_norm, l3_mla_w_q_up, l3_mla_kv_a_norm, l3_mla_w_kv_up,
         l3_mla_q_norm, l3_mla_k_nope_norm, l3_mla_k_rope_norm, l3_mla_w_out),
    ]
    ffn_params = [
        (l0_ffn_norm, l0_ffn_w_in, l0_ffn_w_out),
        (l1_ffn_norm, l1_moe_w_router, l1_moe_w_in, l1_moe_w_out),
        (l2_ffn_norm, l2_ffn_w_in, l2_ffn_w_out),
        (l3_ffn_norm, l3_moe_w_router, l3_moe_w_in, l3_moe_w_out),
    ]

    for i in range(DEPTH):
        if i % N_MIXERS == 0:
            h = h + fox_mixer(h, *mixer_params[i])
        else:
            h = h + mla_mixer(h, angles, *mixer_params[i])
        if i % 2 == 0:
            h = h + dense_swiglu(h, *ffn_params[i])
        else:
            h = h + moe_swiglu(h, *ffn_params[i])
    return h[:, N_META:]
```

```cpp
#include <hip/hip_runtime.h>
#include <hip/hip_bf16.h>
#include <cstdio>
#include <cstdint>
#include <cmath>
#include <type_traits>

constexpr int NB = 4, SEQ = 8192, DM_ = 1024, NMETA = 16, LP = 8448, NREAL = NB * SEQ, NROWS = NREAL + NMETA, RPAD = NREAL + 256, LROWS = NB * LP;
constexpr int LVALID = SEQ + NMETA;
constexpr int DFF = 2816, NEXP = 8, NHEADS = 16;
constexpr int RG_MAX = 67840;
constexpr float EPSN = 1e-6f, LOG2E = 1.4426950408889634f;

#define GAS __attribute__((address_space(1)))
#define LAS __attribute__((address_space(3)))
typedef unsigned short bf16_t;
typedef short bf16x8 __attribute__((ext_vector_type(8)));
typedef float f32x4 __attribute__((ext_vector_type(4)));
typedef float f32x2 __attribute__((ext_vector_type(2)));
typedef unsigned u32x4 __attribute__((ext_vector_type(4)));
typedef unsigned u32x2 __attribute__((ext_vector_type(2)));

typedef __bf16 bf16x2_cv __attribute__((ext_vector_type(2)));
__device__ __forceinline__ unsigned cvt_pk_bf16(float lo, float hi) { const f32x2 v = {lo, hi}; return __builtin_bit_cast(unsigned, __builtin_convertvector(v, bf16x2_cv)); }
__device__ __forceinline__ float bf_lo(unsigned w) { return __uint_as_float(w << 16); }
__device__ __forceinline__ float bf_hi(unsigned w) { return __uint_as_float(w & 0xffff0000u); }
__device__ __forceinline__ float bf2f(bf16_t x) { return __uint_as_float((unsigned)x << 16); }
__device__ __forceinline__ bf16_t f2bf(float f) { return (bf16_t)(cvt_pk_bf16(f, 0.f) & 0xffffu); }
__device__ __forceinline__ unsigned pack4_fp8(float a, float b, float c, float d) {
    a = __builtin_amdgcn_fmed3f(a, -448.f, 448.f); b = __builtin_amdgcn_fmed3f(b, -448.f, 448.f); c = __builtin_amdgcn_fmed3f(c, -448.f, 448.f); d = __builtin_amdgcn_fmed3f(d, -448.f, 448.f);
    int p = __builtin_amdgcn_cvt_pk_fp8_f32(a, b, 0, false); p = __builtin_amdgcn_cvt_pk_fp8_f32(c, d, p, true); return (unsigned)p;
}
constexpr float F8_SX = 16.0f, F8_SH = 8.0f, F8_SW = 128.0f;
__device__ __forceinline__ float fast_sigmoid(float x) { return __builtin_amdgcn_rcpf(1.0f + __builtin_amdgcn_exp2f(-x * LOG2E)); }
__device__ __forceinline__ float wave_sum(float v) {
#pragma unroll
    for (int o = 1; o < 64; o <<= 1) v += __shfl_xor(v, o);
    return v;
}
__device__ __forceinline__ int lpos_to_row(int b, int pos) { return pos < NMETA ? NREAL + pos : b * SEQ + pos - NMETA; }
__device__ __forceinline__ int row_to_lrow(int r) { return r + NMETA + (r >> 13) * (LP - SEQ); }

namespace pg8 {
#define PG8_LAS __attribute__((address_space(3)))
constexpr int BM = 256, BK = 64, HALF = 128, HTB = HALF * BK * 2  , STAGE_BYTES = 8 * HTB, NXCD = 8, WGM = 8;

__host__ __device__ __forceinline__ int lds_byte(int r, int c) { const int st = (r >> 4) * 2 + (c >> 5), rr = r & 15, cc = c & 31, ob = rr * 64 + cc * 2; return st * 1024 + (ob ^ (((ob >> 9) & 1) << 5)); }
__host__ __device__ __forceinline__ void stage_rc(int b, int& R, int& C) { const int st = b / 1024, sb = b % 1024, swz = sb ^ (((sb >> 9) & 1) << 5); R = (st >> 1) * 16 + swz / 64; C = (st & 1) * 32 + (swz % 64) / 2; }
__host__ __device__ __forceinline__ int perm32(int rho) { const int n = rho >> 4, i = rho & 15; return 8 * (i >> 2) + 4 * n + (i & 3); }

struct Unit { int pm, pn, pb; };
struct Gemm { const bf16_t* A; const bf16_t* Bt; int M, N, K; };

__host__ __device__ __forceinline__ int xcd_remap(int wgid, int nwg) { const int q = nwg / NXCD, r = nwg % NXCD, xcd = wgid % NXCD, off = wgid / NXCD; return (xcd < r ? xcd * (q + 1) : r * (q + 1) + (xcd - r) * q) + off; }
struct StaticOrder {
    int nM, nN, nwg, G, c;
    __host__ __device__ void init(int M, int N, int G_, int c_) { nM = M / BM; nN = N / BM; nwg = nM * nN; G = G_; c = c_; }
    __host__ __device__ bool next(int i, Unit& u) const {
        const long L = (long)i * G + c; if (L >= nwg) return false;
        const int wgid = xcd_remap((int)L, nwg);
        const int nig = WGM * nN, gid = wgid / nig, fm = gid * WGM, gsz = (nM - fm) < WGM ? (nM - fm) : WGM;
        u.pm = fm + ((wgid % nig) % gsz); u.pn = (wgid % nig) / gsz; u.pb = u.pn; return true;
    }
    __device__ __forceinline__ void a_ready(const Unit&) const {}
    __device__ __forceinline__ void done(const Unit&) const {}
};
struct MoeOrder {
    int nM, nN, nwg, G, c; int toff[9];
    __device__ bool next(int i, Unit& u) const {
        const long L = (long)i * G + c; if (L >= nwg) return false;
        const int wgid = xcd_remap((int)L, nwg);
        const int nig = WGM * nN, gid = wgid / nig, fm = gid * WGM, gsz = (nM - fm) < WGM ? (nM - fm) : WGM;
        const int pm = fm + ((wgid % nig) % gsz), pn = (wgid % nig) / gsz;
        int e = 0;
#pragma unroll
        for (int k = 1; k < 8; ++k) e += (pm >= toff[k]) ? 1 : 0;
        u.pm = pm; u.pn = pn; u.pb = e * nN + pn; return true;
    }
    __device__ __forceinline__ void a_ready(const Unit&) const {}
    __device__ __forceinline__ void done(const Unit&) const {}
};

typedef f32x4 Acc[2][2][4][2];

__device__ __forceinline__ u32x4 pack8(const f32x4 v0, const f32x4 v1) { u32x4 w; w.x = cvt_pk_bf16(v0[0], v0[1]); w.y = cvt_pk_bf16(v0[2], v0[3]); w.z = cvt_pk_bf16(v1[0], v1[1]); w.w = cvt_pk_bf16(v1[2], v1[3]); return w; }

__device__ __forceinline__ void store_tile_bf16(const Acc& acc, bf16_t* O, int ld, int row_base, int col_base, int wr, int wc, int fr, int fq) {
    const int row0 = row_base + wr * 64 + fr, col0 = col_base + wc * 32 + 8 * fq;
#pragma unroll
    for (int ai = 0; ai < 2; ++ai)
#pragma unroll
        for (int m = 0; m < 4; ++m) { bf16_t* rowp = O + (size_t)(row0 + ai * HALF + m * 16) * ld + col0;
#pragma unroll
            for (int bj = 0; bj < 2; ++bj) *(u32x4*)(rowp + bj * HALF) = pack8(acc[ai][bj][m][0], acc[ai][bj][m][1]); }
}
__device__ __forceinline__ void store_tile_lspace(const Acc& acc, bf16_t* O, int pm, int col_base, int wr, int wc, int fr, int fq) {
    const int col0 = col_base + wc * 32 + 8 * fq;
    if (pm < NREAL / BM) {
        const int row0 = pm * BM + NMETA + (pm >> 5) * (LP - SEQ) + wr * 64 + fr;
#pragma unroll
        for (int ai = 0; ai < 2; ++ai)
#pragma unroll
            for (int m = 0; m < 4; ++m) { bf16_t* rowp = O + (size_t)(row0 + ai * HALF + m * 16) * 1024 + col0;
#pragma unroll
                for (int bj = 0; bj < 2; ++bj) *(u32x4*)(rowp + bj * HALF) = pack8(acc[ai][bj][m][0], acc[ai][bj][m][1]); }
    } else if (wr == 0) {
#pragma unroll
        for (int b = 0; b < NB; ++b) { bf16_t* rowp = O + (size_t)(b * LP + fr) * 1024 + col0;
#pragma unroll
            for (int bj = 0; bj < 2; ++bj) *(u32x4*)(rowp + bj * HALF) = pack8(acc[0][bj][0][0], acc[0][bj][0][1]); }
    }
}

struct EpiStore {
    static constexpr bool PERM = true, AFTER_DRAIN = false;
    bf16_t* O; int ld; float sc;
    __device__ __forceinline__ void operator()(const Acc& acc, const Unit& u, int wr, int wc, int fr, int fq) const {
        const int row0 = u.pm * BM + wr * 64 + fr, col0 = u.pn * BM + wc * 32 + 8 * fq;
#pragma unroll
        for (int ai = 0; ai < 2; ++ai)
#pragma unroll
            for (int m = 0; m < 4; ++m) { bf16_t* rowp = O + (size_t)(row0 + ai * HALF + m * 16) * ld + col0;
#pragma unroll
                for (int bj = 0; bj < 2; ++bj) *(u32x4*)(rowp + bj * HALF) = pack8(acc[ai][bj][m][0] * sc, acc[ai][bj][m][1] * sc); }
    }
};
template <int DKP> __device__ __forceinline__ void store_tile_knorm(const Acc& acc, bf16_t* Kp, const float* gk, int pm, int ht, int wr, int wc, int fr, int fq) {
    const int head = 4 * ht + wc; const int row0 = pm * BM + NMETA + (pm >> 5) * (LP - SEQ) + wr * 64 + fr;
    f32x4 g[2][2];
#pragma unroll
    for (int bj = 0; bj < 2; ++bj)
#pragma unroll
        for (int n = 0; n < 2; ++n) g[bj][n] = *(const f32x4*)(gk + 32 * bj + 8 * fq + 4 * n);
#pragma unroll
    for (int ai = 0; ai < 2; ++ai)
#pragma unroll
        for (int m = 0; m < 4; ++m) { float ss = 0.f;
#pragma unroll
            for (int bj = 0; bj < 2; ++bj)
#pragma unroll
                for (int n = 0; n < 2; ++n) { const f32x4 x = acc[ai][bj][m][n]; ss += (x[0] * x[0] + x[1] * x[1]) + (x[2] * x[2] + x[3] * x[3]); }
            ss += __shfl_xor(ss, 16); ss += __shfl_xor(ss, 32);
            const float rn = __builtin_amdgcn_rsqf(ss * (1.0f / 64.0f) + EPSN);
            bf16_t* rowp = Kp + (size_t)(row0 + ai * HALF + m * 16) * (16 * DKP) + head * DKP + 8 * fq;
#pragma unroll
            for (int bj = 0; bj < 2; ++bj) *(u32x4*)(rowp + 32 * bj) = pack8(acc[ai][bj][m][0] * rn * g[bj][0], acc[ai][bj][m][1] * rn * g[bj][1]); }
}
struct EpiFoxIn {
    static constexpr bool PERM = true, AFTER_DRAIN = false;
    bf16_t* QK; bf16_t* Vp; bf16_t* Gt; float* lf; const float* bfg; bf16_t* Kp; const float* gk;
    __device__ __forceinline__ void operator()(const Acc& acc, const Unit& u, int wr, int wc, int fr, int fq) const {
        asm volatile("" : "+v"(fr), "+v"(fq));
        const int pn = u.pn;
        if (pn < 4) store_tile_bf16(acc, QK, 2048, u.pm * BM, pn * BM, wr, wc, fr, fq);
        else if (pn < 8) store_tile_knorm<80>(acc, Kp, gk, u.pm, pn - 4, wr, wc, fr, fq);
        else if (pn < 12) store_tile_lspace(acc, Vp, u.pm, (pn - 8) * BM, wr, wc, fr, fq);
        else if (pn < 16) store_tile_bf16(acc, Gt, 1024, u.pm * BM, (pn - 12) * BM, wr, wc, fr, fq);
        else if (wc == 0 && fq < 2) {
            const int row0 = u.pm * BM + wr * 64 + fr;
#pragma unroll
            for (int n = 0; n < 2; ++n) { const f32x4 bv = *(const f32x4*)(bfg + 8 * fq + 4 * n);
#pragma unroll
                for (int ai = 0; ai < 2; ++ai)
#pragma unroll
                    for (int m = 0; m < 4; ++m) { f32x4 z = acc[ai][0][m][n] + bv, o;
#pragma unroll
                        for (int j = 0; j < 4; ++j) o[j] = fminf(z[j], 0.f) - log1pf(expf(-fabsf(z[j])));
                        *(f32x4*)(lf + (size_t)(row0 + ai * HALF + m * 16) * 16 + 8 * fq + 4 * n) = o; } }
        }
    }
};
struct EpiKvUp {
    static constexpr bool PERM = true, AFTER_DRAIN = false;
    bf16_t* Kp; const float* gk; bf16_t* Vp;
    __device__ __forceinline__ void operator()(const Acc& acc, const Unit& u, int wr, int wc, int fr, int fq) const {
        asm volatile("" : "+v"(fr), "+v"(fq));
        if (u.pn < 4) store_tile_knorm<96>(acc, Kp, gk, u.pm, u.pn, wr, wc, fr, fq);
        else store_tile_lspace(acc, Vp, u.pm, (u.pn - 4) * BM, wr, wc, fr, fq);
    }
};
template <bool F8> struct EpiSwiglu {
    static constexpr bool PERM = true, AFTER_DRAIN = false;
    void* O; const float* ssp; float sc; int pad_;
    __device__ __forceinline__ void operator()(const Acc& acc, const Unit& u, int wr, int wc, int fr, int fq) const {
        const int row0 = u.pm * BM + wr * 64 + fr, col0 = u.pn * HALF + wc * 32 + 8 * fq;
#pragma unroll
        for (int ai = 0; ai < 2; ++ai) {
            const float ic0 = 1.0f / (sc * sc * (F8 ? F8_SH : 1.0f)); float rsv[4] = {sc, sc, sc, sc}, c0v[4] = {ic0, ic0, ic0, ic0};
            if (ssp) { f32x4 q[4][4];
#pragma unroll
                for (int m = 0; m < 4; ++m)
#pragma unroll
                    for (int k = 0; k < 4; ++k) q[m][k] = *(const f32x4*)(ssp + (size_t)(row0 + ai * HALF + m * 16) * 16 + 4 * k);
#pragma unroll
                for (int m = 0; m < 4; ++m) { float s = 0.f;
#pragma unroll
                    for (int k = 0; k < 4; ++k) s += (q[m][k][0] + q[m][k][1]) + (q[m][k][2] + q[m][k][3]);
                    const float msq = s * (1.0f / 1024.0f) + EPSN; rsv[m] = sc * __builtin_amdgcn_rsqf(msq); c0v[m] = msq * ic0; } }
#pragma unroll
            for (int m = 0; m < 4; ++m) { f32x4 o[2]; const float rs = rsv[m];
                const float k1 = -rs * LOG2E, c0 = c0v[m];
#pragma unroll
                for (int n = 0; n < 2; ++n) { const f32x4 ag = acc[ai][0][m][n], au = acc[ai][1][m][n];
#pragma unroll
                    for (int j = 0; j < 4; ++j) { const float ex = __builtin_amdgcn_exp2f(ag[j] * k1); o[n][j] = (ag[j] * au[j]) * __builtin_amdgcn_rcpf(__builtin_fmaf(ex, c0, c0)); } }
                const size_t off = (size_t)(row0 + ai * HALF + m * 16) * DFF + col0;
                if constexpr (F8) { u32x2 w; w.x = pack4_fp8(o[0][0], o[0][1], o[0][2], o[0][3]); w.y = pack4_fp8(o[1][0], o[1][1], o[1][2], o[1][3]); *(u32x2*)((unsigned char*)O + off) = w; }
                else *(u32x4*)((bf16_t*)O + off) = pack8(o[0], o[1]); } }
    }
};
template <bool WX> struct EpiResidT {
    static constexpr bool PERM = true, AFTER_DRAIN = false;
    const bf16_t* rin; bf16_t* rout; float* ssp; float sc; int pad_;
    __device__ __forceinline__ void operator()(const Acc& acc, const Unit& u, int wr, int wc, int fr, int fq) const {
        asm volatile("" : "+v"(fr), "+v"(fq));
        const int col0 = u.pn * BM + wc * 32 + 8 * fq, row0 = u.pm * BM + wr * 64 + fr;
#pragma unroll
        for (int ai = 0; ai < 2; ++ai) { u32x4 r[1][4][2];
#pragma unroll
            for (int m = 0; m < 4; ++m)
#pragma unroll
                for (int bj = 0; bj < 2; ++bj) r[0][m][bj] = *(const u32x4*)(rin + (size_t)(row0 + ai * HALF + m * 16) * 1024 + col0 + bj * HALF);
#pragma unroll
            for (int m = 0; m < 4; ++m) { const size_t off = (size_t)(row0 + ai * HALF + m * 16) * 1024 + col0; float ss = 0.f;
#pragma unroll
                for (int bj = 0; bj < 2; ++bj) { const u32x4 rr = r[0][m][bj]; const f32x4 a0 = acc[ai][bj][m][0] * sc, a1 = acc[ai][bj][m][1] * sc;
                    const f32x4 o0 = {bf_lo(rr.x) + a0[0], bf_hi(rr.x) + a0[1], bf_lo(rr.y) + a0[2], bf_hi(rr.y) + a0[3]}, o1 = {bf_lo(rr.z) + a1[0], bf_hi(rr.z) + a1[1], bf_lo(rr.w) + a1[2], bf_hi(rr.w) + a1[3]};
                    *(u32x4*)(rout + off + bj * HALF) = pack8(o0, o1);
                    if constexpr (WX) ss += ((o0[0] * o0[0] + o0[1] * o0[1]) + (o0[2] * o0[2] + o0[3] * o0[3])) + ((o1[0] * o1[0] + o1[1] * o1[1]) + (o1[2] * o1[2] + o1[3] * o1[3])); }
                if constexpr (WX) { ss += __shfl_xor(ss, 16); ss += __shfl_xor(ss, 32); if (fq == 0) ssp[(size_t)(row0 + ai * HALF + m * 16) * 16 + 4 * u.pn + wc] = ss; } }
            asm volatile("" ::: "memory"); }
    }
};
typedef int i32x8 __attribute__((ext_vector_type(8))); typedef int i32x4 __attribute__((ext_vector_type(4)));
__device__ __forceinline__ i32x8 cat8(bf16x8 a, bf16x8 b) { return __builtin_shufflevector(__builtin_bit_cast(i32x4, a), __builtin_bit_cast(i32x4, b), 0, 1, 2, 3, 4, 5, 6, 7); }
template <class Epi, class Sched, bool ALIGN_EPI = false, bool SP2 = false, bool F8 = false>
__device__ __forceinline__ void gemm_phase(PG8_LAS unsigned char* lds, const Gemm g, const Sched& S, const Epi& E) {
    int tid_ = threadIdx.x; asm volatile("" : "+v"(tid_));
    const int tid = tid_, wid = __builtin_amdgcn_readfirstlane(tid >> 6), lane = tid & 63, wr = wid >> 2, wc = wid & 3, fr = lane & 15, fq = lane >> 4;
    int K_ = g.K; asm volatile("" : "+s"(K_));     const int K = K_, nt = K / BK;
    unsigned voffA[2], voffB[2];
#pragma unroll
    for (int i = 0; i < 2; ++i) { int R, C; stage_rc(tid * 16 + i * 8192, R, C); const int Rb = Epi::PERM ? ((R & ~31) + perm32(R & 31)) : R;
        voffA[i] = (unsigned)(R * K + C) * 2u; voffB[i] = (unsigned)(Rb * K + C) * 2u; }
    const size_t kstep = (size_t)(BK * 2);
    const size_t hstep = (size_t)HALF * K * 2;
    const size_t tstep = 2 * hstep;
    const unsigned ldsw = (unsigned)wid * 1024u;
    const int aoff = lds_byte(wr * 64 + fr, fq * 8), boff = lds_byte(wc * 32 + fr, fq * 8);
#define PG8_SA(b, h) (((b) * 2 + (h)) * HTB)
#define PG8_SB(b, h) ((4 + (b) * 2 + (h)) * HTB)
#define PG8_STAGE(bufoff, gbase, voff) do { _Pragma("unroll") for (int _i = 0; _i < 2; ++_i) \
        __builtin_amdgcn_global_load_lds((const unsigned*)((const char*)(gbase) + (voff)[_i]), (PG8_LAS unsigned*)(lds + (bufoff) + ldsw + _i * 8192), 16, 0, 0); } while (0)
#define PG8_LDA(dst, b, h) do { _Pragma("unroll") for (int m = 0; m < 4; ++m) { if constexpr (F8) { dst[m] = __builtin_shufflevector(*(const PG8_LAS i32x4*)(lds + PG8_SA(b, h) + aoff + m * 2048), *(const PG8_LAS i32x4*)(lds + PG8_SA(b, h) + aoff + m * 2048 + 1024), 0, 1, 2, 3, 4, 5, 6, 7); } \
        else { _Pragma("unroll") for (int k = 0; k < 2; ++k) dst[m][k] = *(const PG8_LAS bf16x8*)(lds + PG8_SA(b, h) + aoff + m * 2048 + k * 1024); } } } while (0)
#define PG8_LDB(dst, b, h) do { _Pragma("unroll") for (int n = 0; n < 2; ++n) { if constexpr (F8) { dst[n] = __builtin_shufflevector(*(const PG8_LAS i32x4*)(lds + PG8_SB(b, h) + boff + n * 2048), *(const PG8_LAS i32x4*)(lds + PG8_SB(b, h) + boff + n * 2048 + 1024), 0, 1, 2, 3, 4, 5, 6, 7); } \
        else { _Pragma("unroll") for (int k = 0; k < 2; ++k) dst[n][k] = *(const PG8_LAS bf16x8*)(lds + PG8_SB(b, h) + boff + n * 2048 + k * 1024); } } } while (0)
#define PG8_MMA(ai, bj, At, Bt) do { __builtin_amdgcn_s_setprio(1); _Pragma("unroll") for (int m = 0; m < 4; ++m) _Pragma("unroll") for (int n = 0; n < 2; ++n) { \
        if constexpr (F8) asm volatile("v_mfma_scale_f32_16x16x128_f8f6f4 %0, %1, %2, %0, %3, %3 op_sel_hi:[0,0,0]" : "+v"(acc[ai][bj][m][n]) : "v"(Bt[n]), "v"(At[m]), "v"(f8scl));     \
        else { _Pragma("unroll") for (int k = 0; k < 2; ++k) acc[ai][bj][m][n] = __builtin_amdgcn_mfma_f32_16x16x32_bf16(Bt[n][k], At[m][k], acc[ai][bj][m][n], 0, 0, 0); } } __builtin_amdgcn_s_setprio(0); } while (0)
#define PG8_MMAZ(ai, bj, At, Bt) do { if constexpr (F8) { if (t == 0) { __builtin_amdgcn_s_setprio(1); _Pragma("unroll") for (int m = 0; m < 4; ++m) _Pragma("unroll") for (int n = 0; n < 2; ++n) \
        asm volatile("v_mfma_scale_f32_16x16x128_f8f6f4 %0, %1, %2, 0, %3, %3 op_sel_hi:[0,0,0]" : "=v"(acc[ai][bj][m][n]) : "v"(Bt[n]), "v"(At[m]), "v"(f8scl));     \
        __builtin_amdgcn_s_setprio(0); } else PG8_MMA(ai, bj, At, Bt); } else PG8_MMA(ai, bj, At, Bt); } while (0)
#define PG8_WAIT_V(n) asm volatile("s_waitcnt vmcnt(" #n ")" ::: "memory")
#define PG8_WAIT_L(n) asm volatile("s_waitcnt lgkmcnt(" #n ")" ::: "memory")
#define PG8_BAR __builtin_amdgcn_s_barrier()
#define PG8_SCHED __builtin_amdgcn_sched_barrier(0)
    Unit cur, nxt; int ui = 0;
    if (!S.next(0, cur)) return;
    f32x4 acc[2][2][4][2];
    int f8scl = 0x7F7F7F7F; asm volatile("" : "+v"(f8scl));
    using FragT = std::conditional_t<F8, i32x8, bf16x8[2]>;
    FragT At[4], B0[2], B1[2];
    const char* cA = (const char*)g.A + (size_t)cur.pm * tstep; const char* cB = (const char*)g.Bt + (size_t)cur.pb * tstep;
    S.a_ready(cur);
    if constexpr (SP2) {
        PG8_STAGE(PG8_SB(0, 0), cB, voffB); PG8_STAGE(PG8_SB(0, 1), cB + hstep, voffB); PG8_STAGE(PG8_SA(0, 0), cA, voffA); PG8_STAGE(PG8_SA(0, 1), cA + hstep, voffA);
        if (wr == 1) PG8_BAR;
        PG8_WAIT_V(2); PG8_BAR;
        PG8_STAGE(PG8_SB(1, 0), cB + kstep, voffB); PG8_STAGE(PG8_SA(1, 0), cA + kstep, voffA); PG8_STAGE(PG8_SB(1, 1), cB + hstep + kstep, voffB);
        PG8_WAIT_V(6); PG8_BAR;
    } else {
        PG8_STAGE(PG8_SB(0, 0), cB, voffB); PG8_STAGE(PG8_SA(0, 0), cA, voffA); PG8_STAGE(PG8_SB(0, 1), cB + hstep, voffB); PG8_STAGE(PG8_SA(0, 1), cA + hstep, voffA);
        if (wr == 1) PG8_BAR;
        PG8_WAIT_V(4); PG8_BAR;
        PG8_STAGE(PG8_SB(1, 0), cB + kstep, voffB); PG8_STAGE(PG8_SA(1, 0), cA + kstep, voffA); PG8_STAGE(PG8_SB(1, 1), cB + hstep + kstep, voffB);
        PG8_WAIT_V(6); PG8_BAR;
    }
    for (;;) {
        if constexpr (!F8) {
#pragma unroll
        for (int a = 0; a < 2; ++a)
#pragma unroll
            for (int b = 0; b < 2; ++b)
#pragma unroll
                for (int m = 0; m < 4; ++m)
#pragma unroll
                    for (int n = 0; n < 2; ++n) acc[a][b][m][n] = (f32x4){0.f, 0.f, 0.f, 0.f}; }
        const bool has_next = S.next(ui + 1, nxt);
        const char* nA = has_next ? (const char*)g.A + (size_t)nxt.pm * tstep : cA; const char* nB = has_next ? (const char*)g.Bt + (size_t)nxt.pb * tstep : cB;
        int t = 0;
        do {
            const bool last = (t == nt - 2);
            const char* a1 = cA + (size_t)(t + 1) * kstep;
            const char* a2 = last ? nA : cA + (size_t)(t + 2) * kstep; const char* b2 = last ? nB : cB + (size_t)(t + 2) * kstep;
            const char* a3 = a2 + kstep; const char* b3 = b2 + kstep;
            if (last && has_next) S.a_ready(nxt);
            if constexpr (SP2) {
            PG8_LDB(B0, 0, 0); PG8_LDB(B1, 0, 1); PG8_SCHED; PG8_LDA(At, 0, 0); PG8_STAGE(PG8_SA(1, 1), a1 + hstep, voffA);
            PG8_WAIT_V(8); PG8_WAIT_L(0); PG8_BAR; PG8_MMAZ(0, 0, At, B0); PG8_MMAZ(0, 1, At, B1); PG8_BAR; PG8_SCHED;
            PG8_LDA(At, 0, 1); PG8_STAGE(PG8_SB(0, 0), b2, voffB); PG8_STAGE(PG8_SB(0, 1), b2 + hstep, voffB); PG8_STAGE(PG8_SA(0, 0), a2, voffA);
            PG8_WAIT_V(8); PG8_WAIT_L(0); PG8_BAR; PG8_MMAZ(1, 0, At, B0); PG8_MMAZ(1, 1, At, B1); PG8_BAR; PG8_SCHED;
            PG8_LDB(B0, 1, 0); PG8_LDB(B1, 1, 1); PG8_SCHED; PG8_LDA(At, 1, 0); PG8_STAGE(PG8_SA(0, 1), a2 + hstep, voffA);
            PG8_WAIT_V(8); PG8_WAIT_L(0); PG8_BAR; PG8_MMA(0, 0, At, B0); PG8_MMA(0, 1, At, B1); PG8_BAR; PG8_SCHED;
            PG8_LDA(At, 1, 1); PG8_STAGE(PG8_SB(1, 0), b3, voffB); PG8_STAGE(PG8_SB(1, 1), b3 + hstep, voffB); PG8_STAGE(PG8_SA(1, 0), a3, voffA);
            PG8_WAIT_V(8); PG8_WAIT_L(0); PG8_BAR; PG8_MMA(1, 0, At, B0); PG8_MMA(1, 1, At, B1); PG8_BAR; PG8_SCHED;
            } else {
            PG8_LDB(B0, 0, 0); PG8_SCHED; PG8_LDA(At, 0, 0); PG8_STAGE(PG8_SA(1, 1), a1 + hstep, voffA);
            PG8_WAIT_L(8); PG8_BAR; PG8_WAIT_L(0); PG8_MMA(0, 0, At, B0); PG8_BAR; PG8_SCHED;
            PG8_LDB(B1, 0, 1); PG8_STAGE(PG8_SB(0, 0), b2, voffB);
            PG8_BAR; PG8_WAIT_L(0); PG8_MMA(0, 1, At, B1); PG8_BAR;
            PG8_LDA(At, 0, 1); PG8_STAGE(PG8_SA(0, 0), a2, voffA);
            PG8_BAR; PG8_WAIT_L(0); PG8_MMA(1, 0, At, B0); PG8_BAR; PG8_SCHED;
            PG8_STAGE(PG8_SB(0, 1), b2 + hstep, voffB);
            PG8_WAIT_V(6); PG8_BAR; PG8_MMA(1, 1, At, B1); PG8_BAR;
            PG8_LDB(B0, 1, 0); PG8_SCHED; PG8_LDA(At, 1, 0); PG8_STAGE(PG8_SA(0, 1), a2 + hstep, voffA);
            PG8_WAIT_L(8); PG8_BAR; PG8_WAIT_L(0); PG8_MMA(0, 0, At, B0); PG8_BAR; PG8_SCHED;
            PG8_LDB(B1, 1, 1); PG8_STAGE(PG8_SB(1, 0), b3, voffB);
            PG8_BAR; PG8_WAIT_L(0); PG8_MMA(0, 1, At, B1); PG8_BAR;
            PG8_LDA(At, 1, 1); PG8_STAGE(PG8_SA(1, 0), a3, voffA);
            PG8_BAR; PG8_WAIT_L(0); PG8_MMA(1, 0, At, B0); PG8_BAR; PG8_SCHED;
            PG8_STAGE(PG8_SB(1, 1), b3 + hstep, voffB);
            PG8_WAIT_V(6); PG8_BAR; PG8_MMA(1, 1, At, B1); PG8_BAR;
            }
            t += 2;
        } while (t < nt);
        if constexpr (F8) asm volatile("s_nop 15\n\ts_nop 15" ::: "memory");
        if constexpr (ALIGN_EPI) { if (wr == 0) PG8_BAR; }
        if constexpr (!Epi::AFTER_DRAIN) { E(acc, cur, wr, wc, fr, fq); S.done(cur); }
        if (!has_next) break;
        cur = nxt; cA = nA; cB = nB; ++ui;
        if constexpr (ALIGN_EPI) { if (wr == 1) PG8_BAR; }
    }
    PG8_WAIT_V(0);
    if constexpr (!ALIGN_EPI) { if (wr == 0) PG8_BAR; }
    PG8_BAR;
    if constexpr (Epi::AFTER_DRAIN) { E.fused(acc, cur, wr, wc, fr, fq, lds, wid, lane); S.done(cur); }
#undef PG8_SA
#undef PG8_SB
#undef PG8_STAGE
#undef PG8_LDA
#undef PG8_LDB
#undef PG8_MMA
#undef PG8_MMAZ
#undef PG8_WAIT_V
#undef PG8_WAIT_L
#undef PG8_BAR
#undef PG8_SCHED
}
}

namespace attn_body {
using s16x4=__attribute__((ext_vector_type(4)))short;
using f32x16=__attribute__((ext_vector_type(16)))float;
constexpr int NW=8,QBLK=32,QB=QBLK*NW,KVBLK=64;
__device__ __forceinline__ int crow(int r,int hi){return (r&3)+8*(r>>2)+4*hi;}
#define SBAR() __builtin_amdgcn_sched_barrier(0)
__device__ __forceinline__ void cmask(f32x16&p0,f32x16&p1,int jb,int qrel,int hi){
  const float NEG=-INFINITY; int kb=64*jb+4*hi;
  #pragma unroll
  for(int r=0;r<16;++r){int kv=kb+(r&3)+8*(r>>2); if(kv>qrel)p0[r]=NEG; if(kv+32>qrel)p1[r]=NEG;}
}
constexpr int NKSLOT=4, NVSLOT=3, VSLOTB=8192, KRING_MAX=NKSLOT*6*2048;
constexpr int LDS_K=0, LDS_V=KRING_MAX, LDS_WS=LDS_V+NVSLOT*VSLOTB, LDS_OST=LDS_WS+NW*64*4, LDS_BYTES=LDS_OST+NW*4096;
__device__ __forceinline__ void glds16(const void*gbase,unsigned voff,unsigned lds_dst){unsigned keep;
  asm volatile("s_mov_b32 %0, m0\n\ts_mov_b32 m0, %3\n\ts_nop 0\n\tglobal_load_lds_dwordx4 %1, %2\n\ts_mov_b32 m0, %0":"=&s"(keep):"v"(voff),"s"(gbase),"s"(lds_dst):"memory");}
__device__ __forceinline__ float max3f(float a,float b,float c){float r;asm("v_max3_f32 %0, %1, %2, %3":"=v"(r):"v"(a),"v"(b),"v"(c));return r;}
__device__ __forceinline__ float max2f(float a,float b){float r;asm("v_max_f32_e32 %0, %1, %2":"=v"(r):"v"(a),"v"(b));return r;}
__device__ __forceinline__ float fadd_s(float a,float b){float r;asm("v_add_f32_e32 %0, %1, %2":"=v"(r):"v"(a),"v"(b));return r;}
__device__ __forceinline__ float fsub_s(float a,float b){float r;asm("v_sub_f32_e32 %0, %1, %2":"=v"(r):"v"(a),"v"(b));return r;}
typedef float f32x2_t __attribute__((ext_vector_type(2))); typedef __bf16 bf16x2_t __attribute__((ext_vector_type(2)));
__device__ __forceinline__ unsigned cvtpk_s(float lo,float hi){f32x2_t v={lo,hi};bf16x2_t b=__builtin_convertvector(v,bf16x2_t);return __builtin_bit_cast(unsigned,b);}
__device__ __forceinline__ bf16_t f2bf_s(float x){__bf16 b=(__bf16)x;return __builtin_bit_cast(unsigned short,b);}
#define WAIT_BAR(N) asm volatile("s_waitcnt vmcnt(" #N ") lgkmcnt(0)\n\ts_barrier":::"memory")

template<int NKS> __device__ __forceinline__ void qkt(f32x16&p0,f32x16&p1,const char*Kslot,const bf16x8*qr,const f32x16&negm,int r32,int hi){
  const char*kb=Kslot+hi*1024+r32*16;
  #pragma unroll
  for(int d0=0;d0<NKS;++d0){
    const bf16x8 b0=*reinterpret_cast<const bf16x8*>(kb+d0*2048);
    const bf16x8 b1=*reinterpret_cast<const bf16x8*>(kb+d0*2048+512);
    if(d0==0){p0=__builtin_amdgcn_mfma_f32_32x32x16_bf16(b0,qr[0],negm,0,0,0);p1=__builtin_amdgcn_mfma_f32_32x32x16_bf16(b1,qr[0],negm,0,0,0);}
    else{p0=__builtin_amdgcn_mfma_f32_32x32x16_bf16(b0,qr[d0],p0,0,0,0);p1=__builtin_amdgcn_mfma_f32_32x32x16_bf16(b1,qr[d0],p1,0,0,0);}}
}
typedef __attribute__((address_space(3))) const char* lds_cptr;
typedef short v4i16_t __attribute__((ext_vector_type(4)));
#define LDSV8(p) (*(const __attribute__((address_space(3))) bf16x8*)(p))
__device__ __forceinline__ void kload8(bf16x8*kf,lds_cptr kp){
  kf[0]=LDSV8(kp);      kf[1]=LDSV8(kp+512);
  kf[2]=LDSV8(kp+2048); kf[3]=LDSV8(kp+2560);
  kf[4]=LDSV8(kp+4096); kf[5]=LDSV8(kp+4608);
  kf[6]=LDSV8(kp+6144); kf[7]=LDSV8(kp+6656);
}
__device__ __forceinline__ void kload2(bf16x8*kf,lds_cptr kp,int j){ kf[2*j]=LDSV8(kp+j*2048); kf[2*j+1]=LDSV8(kp+j*2048+512); }
__device__ __forceinline__ s16x4 vtr(lds_cptr p){ return __builtin_bit_cast(s16x4,__builtin_amdgcn_ds_read_tr16_b64_v4i16((__attribute__((address_space(3))) v4i16_t*)p)); }
__device__ __forceinline__ float rowmax(const f32x16&p0,const f32x16&p1){
  float a=max3f(p0[0],p0[1],p1[0]),b=max3f(p0[2],p0[3],p1[1]);a=max3f(a,p1[2],p1[3]);
  #pragma unroll
  for(int r=4;r<16;r+=4){a=max3f(a,p0[r],p0[r+1]);b=max3f(b,p0[r+2],p0[r+3]);a=max3f(a,p1[r],p1[r+1]);b=max3f(b,p1[r+2],p1[r+3]);}
  const float m=max2f(a,b);
  auto rr=__builtin_amdgcn_permlane32_swap(__float_as_uint(m),__float_as_uint(m),false,false);
  return max2f(__uint_as_float(rr[0]),__uint_as_float(rr[1]));
}
__device__ __forceinline__ float pair_sum(float v){ auto rr=__builtin_amdgcn_permlane32_swap(__float_as_uint(v),__float_as_uint(v),false,false); return __uint_as_float(rr[0])+__uint_as_float(rr[1]); }
__device__ __forceinline__ void pv(f32x16*o,int vb,bf16x8 pa0,bf16x8 pa1,bf16x8 pa2,bf16x8 pa3){
  #pragma unroll
  for(int d0=0;d0<2;++d0){s16x4 lo[4],hi[4];
    #pragma unroll
    for(int ks=0;ks<4;++ks){
      asm volatile("ds_read_b64_tr_b16 %0,%1 offset:%c2":"=&v"(lo[ks]):"v"(vb),"i"(d0*4096+ks*1024):"memory");
      asm volatile("ds_read_b64_tr_b16 %0,%1 offset:%c2":"=&v"(hi[ks]):"v"(vb),"i"(d0*4096+ks*1024+512):"memory");}
    asm volatile("s_waitcnt lgkmcnt(0)":::"memory");SBAR();
    #define PK(k) (bf16x8){lo[k][0],lo[k][1],lo[k][2],lo[k][3],hi[k][0],hi[k][1],hi[k][2],hi[k][3]}
    o[d0]=__builtin_amdgcn_mfma_f32_32x32x16_bf16(pa0,PK(0),o[d0],0,0,0);
    o[d0]=__builtin_amdgcn_mfma_f32_32x32x16_bf16(pa1,PK(1),o[d0],0,0,0);
    o[d0]=__builtin_amdgcn_mfma_f32_32x32x16_bf16(pa2,PK(2),o[d0],0,0,0);
    o[d0]=__builtin_amdgcn_mfma_f32_32x32x16_bf16(pa3,PK(3),o[d0],0,0,0);
    #undef PK
  }
}
struct AttnArgs { const bf16_t* Q; const bf16_t* K; const bf16_t* V; bf16_t* O; const bf16_t* G; const float* gq; const float* ctab; const float* rope; };

template<int NKS,int MODE,int THRL,bool FIXREF> __device__ __forceinline__ void attn_unit(int b,int h,int qb,const AttnArgs&T,char*shm){
  constexpr int DKP=16*NKS, KP=16*DKP, KSLOT=NKS*2048, NX=2*NKS-8, NQ=(MODE==0)?4:6, DQ=NQ*16, QP=(MODE==0)?2048:1536;
  static_assert(NKS==5||NKS==6,"NKS"); static_assert((MODE==0&&NKS==5)||(MODE==1&&NKS==6),"mode/NKS");
  int tid_=threadIdx.x; asm volatile("":"+v"(tid_)); const int tid=tid_,lane=tid&63,r32=lane&31,hi=lane>>5; const int wid=__builtin_amdgcn_readfirstlane(tid>>6);
  const bf16_t*Kh_=T.K+(size_t)b*LP*KP+h*DKP,*Vh_=T.V+(size_t)b*LP*1024+h*64; const int q0=qb*QB; const bf16_t*Kh=Kh_,*Vh=Vh_;
  int NT=(q0+QB)/KVBLK;
  if constexpr(MODE==0){
    constexpr float FOX_SKIP=50.f;
    const float cq0=T.ctab[(size_t)lpos_to_row(b,q0)*16+h];
    int nskip=0;
    #pragma unroll
    for(int i=0;i<3;++i){ const int j=lane+64*i; bool sk=false;
      if(j<NT){ const int p=64*j+63; const float ce=T.ctab[(size_t)lpos_to_row(b,p<LVALID?p:LVALID-1)*16+h]; sk=(ce>cq0+FOX_SKIP); }
      nskip+=__builtin_popcountll(__ballot(sk)); }
    int ts=nskip&~1; if(ts>NT-4)ts=NT-4; ts=__builtin_amdgcn_readfirstlane(ts);
    NT-=ts; Kh+=(size_t)ts*KVBLK*KP; Vh+=(size_t)ts*KVBLK*1024;
  }
  const unsigned lds0=(unsigned)(uintptr_t)shm;
  float*wsf=(float*)(shm+LDS_WS)+wid*64;
  const int c2=8+(wid&(NX-1));
  const unsigned kvoff=(unsigned)lane*(KP*2), vvoff=(unsigned)((lane>>2)*2048+(lane&3)*16);
  const char*kbase1=(const char*)(Kh+wid*8),*kbase2=(const char*)(Kh+c2*8),*vbase=(const char*)(Vh+(size_t)(16*(wid&3))*1024+(wid>>2)*32);
  const unsigned kdst=lds0+LDS_K+wid*1024, kdst2=lds0+LDS_K+c2*1024, vdst=lds0+LDS_V+wid*1024;
  #define DMA_K(t,slot) do{ glds16(kbase1+(size_t)(t)*(KVBLK*KP*2),kvoff,(unsigned)__builtin_amdgcn_readfirstlane(kdst+(slot))); glds16(kbase2+(size_t)(t)*(KVBLK*KP*2),kvoff,(unsigned)__builtin_amdgcn_readfirstlane(kdst2+(slot))); }while(0)
  #define DMA_V(t,slot) glds16(vbase+(size_t)(t)*(KVBLK*2048),vvoff,(unsigned)__builtin_amdgcn_readfirstlane(vdst+(slot)))
  const int vb0=(int)(lds0+LDS_V)+((lane>>4)&1)*32+(lane&3)*8+(4*hi+((lane&15)>>2))*64;
  const char*Kbase=shm+LDS_K; bf16x8 kf[8];
  const lds_cptr shm3=(lds_cptr)shm; const lds_cptr kp0=shm3+LDS_K+hi*1024+r32*16; const lds_cptr vp0=shm3+LDS_V+((lane>>4)&1)*32+(lane&3)*8+(4*hi+((lane&15)>>2))*64;
  DMA_K(0,0);DMA_V(0,0);DMA_K(1,KSLOT);
  bf16x8 qr[NKS];
  {
    const int pos=q0+wid*QBLK+r32, posc=pos<LVALID?pos:LVALID-1;
    const int rq=lpos_to_row(b,posc);
    const bf16_t*qp=T.Q+(size_t)rq*QP+h*DQ+hi*8;
    u32x4 raw[NQ]; float xf[NQ][8]; float ss=0.f;
    #pragma unroll
    for(int d0=0;d0<NQ;++d0)raw[d0]=*(const u32x4*)(qp+d0*16);
    #pragma unroll
    for(int d0=0;d0<NQ;++d0){
      #pragma unroll
      for(int j=0;j<4;++j){const unsigned w=raw[d0][j]; xf[d0][2*j]=bf_lo(w); xf[d0][2*j+1]=bf_hi(w); ss+=xf[d0][2*j]*xf[d0][2*j]+xf[d0][2*j+1]*xf[d0][2*j+1];}}
    ss=pair_sum(ss);
    const float C2F=((MODE==0)?0.125f:0.10206207261596575f)*LOG2E;
    const float rn=__builtin_amdgcn_rsqf(ss*(1.0f/DQ)+EPSN);
    #pragma unroll
    for(int d0=0;d0<NQ;++d0){const f32x4 g0=*(const f32x4*)(T.gq+d0*16+hi*8),g1=*(const f32x4*)(T.gq+d0*16+hi*8+4);
      #pragma unroll
      for(int j=0;j<4;++j){xf[d0][j]*=rn*g0[j]; xf[d0][4+j]*=rn*g1[j];}}
    if constexpr(MODE==1){
      const float*rp=T.rope+(size_t)(b*LP+posc)*32+hi*8;
      const f32x4 c0=*(const f32x4*)(rp),c1=*(const f32x4*)(rp+4),s0=*(const f32x4*)(rp+16),s1=*(const f32x4*)(rp+20);
      #pragma unroll
      for(int j=0;j<8;++j){const float c=j<4?c0[j&3]:c1[j&3],s=j<4?s0[j&3]:s1[j&3]; const float x1=xf[4][j],x2=xf[5][j]; xf[4][j]=x1*c-x2*s; xf[5][j]=x2*c+x1*s;}
    }
    #pragma unroll
    for(int d0=0;d0<NQ;++d0){u32x4 w;
      #pragma unroll
      for(int j=0;j<4;++j)w[j]=cvtpk_s(xf[d0][2*j]*C2F,xf[d0][2*j+1]*C2F);
      qr[d0]=__builtin_bit_cast(bf16x8,w);}
    if constexpr(MODE==0){
      const float cq=T.ctab[(size_t)rq*16+h]*LOG2E;
      const bf16_t h1=f2bf_s(cq); const float f1=bf2f(h1); const bf16_t h2=f2bf_s(cq-f1); const float f2=bf2f(h2); const bf16_t h3=f2bf_s(cq-f1-f2);
      u32x4 w; w.x=0x3F803F80u; w.y=0x3F80u|((unsigned)h1<<16); w.z=(unsigned)h2|((unsigned)h3<<16); w.w=0u;
      if(hi)w=(u32x4){0u,0u,0u,0u};
      qr[4]=__builtin_bit_cast(bf16x8,w);
    }
  }
  float mhat=0.f,l_reg=0.f;f32x16 o[2];o[0]=f32x16{};o[1]=f32x16{};f32x16 negm=f32x16{};if constexpr(!FIXREF)asm volatile("":"+v"(negm));
  const int qrel=wid*QBLK+r32;
  #define CMASK(P0,P1,t) do{int jb_=(t)-(NT-4); if(jb_>=0)cmask(P0,P1,jb_,qrel,hi);}while(0)
  bool resc=false;
  #define START(P0,P1) do{ if constexpr(!FIXREF){ const float rm=rowmax(P0,P1); resc=false; \
    { const float dl=rm; mhat=fadd_s(mhat,dl); \
      _Pragma("unroll") for(int r=0;r<16;++r){P0[r]=fsub_s(P0[r],dl);P1[r]=fsub_s(P1[r],dl);} \
      _Pragma("unroll") for(int r=0;r<16;++r)negm[r]=-mhat; asm volatile("":"+v"(negm)); } } \
    _Pragma("unroll") for(int r=0;r<16;++r)P0[r]=__builtin_amdgcn_exp2f(P0[r]); }while(0)
  #define RESC() do{ if constexpr(!FIXREF){ if(resc){ asm volatile("s_waitcnt lgkmcnt(0)":::"memory"); \
      _Pragma("unroll") for(int d_=0;d_<2;++d_) _Pragma("unroll") for(int r=0;r<16;++r)o[d_][r]*=wsf[crow(r,hi)]; } } }while(0)
  f32x16 pA0,pA1,pB0,pB1;
  int ks_prev=0,ks_cur=0,ks_next=KSLOT;
  int vs_prev=0,vs_cur=0,vs_next=VSLOTB;
  #define ROT() do{ks_prev=ks_cur;ks_cur=ks_next;ks_next=(ks_next==(NKSLOT-1)*KSLOT)?0:ks_next+KSLOT; vs_prev=vs_cur;vs_cur=vs_next;vs_next=(vs_next==(NVSLOT-1)*VSLOTB)?0:vs_next+VSLOTB;}while(0)
  DMA_K(2,2*KSLOT);
  WAIT_BAR(5);
  qkt<NKS>(pA0,pA1,Kbase,qr,negm,r32,hi);asm volatile("s_nop 15\n\ts_nop 7":"+v"(pA0),"+v"(pA1));CMASK(pA0,pA1,0);
  START(pA0,pA1);
  _Pragma("unroll") for(int r=0;r<16;++r)pA1[r]=__builtin_amdgcn_exp2f(pA1[r]);
  WAIT_BAR(0);
  DMA_K(3,3*KSLOT);DMA_V(1,VSLOTB);
  ROT();
  kload8(kf,kp0+ks_cur);
  s16x4 vlo[8],vhi[8]; u32x4 pw0,pw1,pw2,pw3;
  #define PKW(P,B) cvtpk_s(P[B],P[B+1])
  #define PAF(k) __builtin_bit_cast(bf16x8,pw##k)
  #define VFR(i) (bf16x8){vlo[i][0],vlo[i][1],vlo[i][2],vlo[i][3],vhi[i][0],vhi[i][1],vhi[i][2],vhi[i][3]}
  #define PIN(x) asm volatile("":"+v"(x))
  #define MX3(a,b,c) __builtin_fmaxf(__builtin_fmaxf((a),(b)),(c))
  #define GAPA(MF,A0,A1,A2,A3,W0,W1,PW) do{ MF; sacc+=A0; sacc+=A1; sacc+=A2; sacc+=A3; PIN(sacc); W0; W1; PIN(PW); SBAR(); }while(0)
  #define EX(v) __builtin_amdgcn_exp2f(v)
  #define GAPB(MF,X,B) do{ MF; X[B]=EX(X[B]); X[B+1]=EX(X[B+1]); X[B+2]=EX(X[B+2]); X[B+3]=EX(X[B+3]); PIN(X); SBAR(); }while(0)
  #define VRD(i) do{ vlo[i]=vtr(vp_+(((i)>>2)*4096+((i)&3)*1024)); vhi[i]=vtr(vp_+(((i)>>2)*4096+((i)&3)*1024+512)); }while(0)
  #define KRD(G,j) do{ if(G){ kload2(kf,kp0+ks_next,j); SBAR(); } }while(0)
  #define XKRD() do{ const lds_cptr kx_=kp0+ks_cur; kf[0]=LDSV8(kx_+4*2048); kf[1]=LDSV8(kx_+4*2048+512); if constexpr(NKS>5){ kf[2]=LDSV8(kx_+5*2048); kf[3]=LDSV8(kx_+5*2048+512); } SBAR(); }while(0)
  #define XMMA(C0,C1) do{ C0=__builtin_amdgcn_mfma_f32_32x32x16_bf16(kf[0],qr[4],C0,0,0,0); C1=__builtin_amdgcn_mfma_f32_32x32x16_bf16(kf[1],qr[4],C1,0,0,0); \
    if constexpr(NKS>5){ C0=__builtin_amdgcn_mfma_f32_32x32x16_bf16(kf[2],qr[5],C0,0,0,0); C1=__builtin_amdgcn_mfma_f32_32x32x16_bf16(kf[3],qr[5],C1,0,0,0); } SBAR(); }while(0)
  #define STEP(C0,C1,P0,P1,t,GK,GV,GL) do{ SBAR(); \
    const lds_cptr vp_=vp0+vs_prev; \
    VRD(0); SBAR(); float sacc=(P0[0]+P0[1]); \
    GAPA(C0=__builtin_amdgcn_mfma_f32_32x32x16_bf16(kf[0],qr[0],negm,0,0,0), P0[2],P0[3],P0[4],P0[5],     pw0[0]=PKW(P0,0), pw0[1]=PKW(P0,2), pw0); \
    VRD(4); SBAR(); GAPA(C1=__builtin_amdgcn_mfma_f32_32x32x16_bf16(kf[1],qr[0],negm,0,0,0), P0[6],P0[7],P0[8],P0[9],     pw0[2]=PKW(P0,4), pw0[3]=PKW(P0,6), pw0); \
    VRD(1); SBAR(); GAPA(C0=__builtin_amdgcn_mfma_f32_32x32x16_bf16(kf[2],qr[1],C0,0,0,0),   P0[10],P0[11],P0[12],P0[13], pw1[0]=PKW(P0,8), pw1[1]=PKW(P0,10), pw1); \
    VRD(5); SBAR(); GAPA(C1=__builtin_amdgcn_mfma_f32_32x32x16_bf16(kf[3],qr[1],C1,0,0,0),   P0[14],P0[15],P1[0],P1[1],   pw1[2]=PKW(P0,12),pw1[3]=PKW(P0,14), pw1); \
    XKRD(); \
    VRD(2); SBAR(); GAPA(C0=__builtin_amdgcn_mfma_f32_32x32x16_bf16(kf[4],qr[2],C0,0,0,0),   P1[2],P1[3],P1[4],P1[5],     pw2[0]=PKW(P1,0), pw2[1]=PKW(P1,2), pw2); \
    VRD(6); SBAR(); GAPA(C1=__builtin_amdgcn_mfma_f32_32x32x16_bf16(kf[5],qr[2],C1,0,0,0),   P1[6],P1[7],P1[8],P1[9],     pw2[2]=PKW(P1,4), pw2[3]=PKW(P1,6), pw2); \
    VRD(3); SBAR(); GAPA(C0=__builtin_amdgcn_mfma_f32_32x32x16_bf16(kf[6],qr[3],C0,0,0,0),   P1[10],P1[11],P1[12],P1[13], pw3[0]=PKW(P1,8), pw3[1]=PKW(P1,10), pw3); \
    VRD(7); SBAR(); GAPA(C1=__builtin_amdgcn_mfma_f32_32x32x16_bf16(kf[7],qr[3],C1,0,0,0),   P1[14],P1[15],0.f,0.f,       pw3[2]=PKW(P1,12),pw3[3]=PKW(P1,14), pw3); \
    XMMA(C0,C1); \
    l_reg+=sacc; \
    if(GK){DMA_K((t)+3,ks_prev);} if(GV){DMA_V((t)+1,vs_next);} \
    CMASK(C0,C1,t); \
    if constexpr(!FIXREF){ float a=MX3(C0[0],C0[1],C1[0]),b=MX3(C0[2],C0[3],C1[1]); a=MX3(a,C1[2],C1[3]); \
      _Pragma("unroll") for(int r=4;r<16;r+=4){a=MX3(a,C0[r],C0[r+1]);b=MX3(b,C0[r+2],C0[r+3]);a=MX3(a,C1[r],C1[r+1]);b=MX3(b,C1[r+2],C1[r+3]);} \
      float rm=__builtin_fmaxf(a,b); { auto rr=__builtin_amdgcn_permlane32_swap(__float_as_uint(rm),__float_as_uint(rm),false,false); rm=__builtin_fmaxf(__uint_as_float(rr[0]),__uint_as_float(rr[1])); } \
      resc=false; \
      if(__builtin_expect(__any(rm>(float)THRL),0)){ const float dl=__builtin_fmaxf(rm,0.f); mhat+=dl; \
        _Pragma("unroll") for(int r=0;r<16;++r){C0[r]-=dl;C1[r]-=dl;} \
        _Pragma("unroll") for(int r=0;r<16;++r)negm[r]=-mhat; asm volatile("":"+v"(negm)); \
        const float f=__builtin_amdgcn_exp2f(-dl); l_reg*=f; if(hi==0)wsf[r32]=f; resc=true; } } \
    SBAR(); \
    GAPB(o[0]=__builtin_amdgcn_mfma_f32_32x32x16_bf16(PAF(0),VFR(0),o[0],0,0,0), C0,0); \
    GAPB(o[1]=__builtin_amdgcn_mfma_f32_32x32x16_bf16(PAF(0),VFR(4),o[1],0,0,0), C0,4); \
    KRD(GL,0); GAPB(o[0]=__builtin_amdgcn_mfma_f32_32x32x16_bf16(PAF(1),VFR(1),o[0],0,0,0), C0,8); \
    KRD(GL,1); GAPB(o[1]=__builtin_amdgcn_mfma_f32_32x32x16_bf16(PAF(1),VFR(5),o[1],0,0,0), C0,12); \
    KRD(GL,2); GAPB(o[0]=__builtin_amdgcn_mfma_f32_32x32x16_bf16(PAF(2),VFR(2),o[0],0,0,0), C1,0); \
    KRD(GL,3); GAPB(o[1]=__builtin_amdgcn_mfma_f32_32x32x16_bf16(PAF(2),VFR(6),o[1],0,0,0), C1,4); \
    GAPB(o[0]=__builtin_amdgcn_mfma_f32_32x32x16_bf16(PAF(3),VFR(3),o[0],0,0,0), C1,8); \
    GAPB(o[1]=__builtin_amdgcn_mfma_f32_32x32x16_bf16(PAF(3),VFR(7),o[1],0,0,0), C1,12); \
    }while(0)
  int t=1;
  #undef CMASK
  #define CMASK(P0,P1,t) do{}while(0)
  for(;t+5<NT;t+=2){
    STEP(pB0,pB1,pA0,pA1,t,true,true,true);     WAIT_BAR(3); RESC(); ROT();
    STEP(pA0,pA1,pB0,pB1,t+1,true,true,true);   WAIT_BAR(3); RESC(); ROT();
  }
  #undef CMASK
  #define CMASK(P0,P1,t) do{int jb_=(t)-(NT-4); if(jb_>=0)cmask(P0,P1,jb_,qrel,hi);}while(0)
  #define ENDW(tt) do{ if((tt)+3<NT){WAIT_BAR(3);} else if((tt)+2<NT){WAIT_BAR(1);} else {WAIT_BAR(0);} }while(0)
  for(;t+1<NT;t+=2){
    STEP(pB0,pB1,pA0,pA1,t,(t+3<NT),(t+1<NT),(t+1<NT));       ENDW(t);   RESC(); ROT();
    STEP(pA0,pA1,pB0,pB1,t+1,(t+4<NT),(t+2<NT),(t+2<NT));     ENDW(t+1); RESC(); ROT();
  }
  STEP(pB0,pB1,pA0,pA1,NT-1,false,false,false); RESC();
  { float sacc=pB0[0]+pB0[1]; _Pragma("unroll") for(int r=2;r<16;++r)sacc+=pB0[r]; _Pragma("unroll") for(int r=0;r<16;++r)sacc+=pB1[r]; l_reg+=sacc;
    pw0=(u32x4){PKW(pB0,0),PKW(pB0,2),PKW(pB0,4),PKW(pB0,6)};pw1=(u32x4){PKW(pB0,8),PKW(pB0,10),PKW(pB0,12),PKW(pB0,14)};pw2=(u32x4){PKW(pB1,0),PKW(pB1,2),PKW(pB1,4),PKW(pB1,6)};pw3=(u32x4){PKW(pB1,8),PKW(pB1,10),PKW(pB1,12),PKW(pB1,14)};
    SBAR(); pv(o,vb0+vs_cur,PAF(0),PAF(1),PAF(2),PAF(3)); }
  #undef PKW
  #undef PAF
  #undef VFR
  #undef PIN
  #undef MX3
  #undef GAPA
  #undef GAPB
  #undef EX
  #undef VRD
  #undef KRD
  #undef XKRD
  #undef XMMA
  #undef STEP
  #undef ENDW
  u32x4 gpre[4]={};
  if constexpr(MODE==0){
    #pragma unroll
    for(int i=0;i<4;++i){const int row=i*8+(lane>>3),ch=lane&7; const int p=q0+wid*QBLK+row;
      gpre[i]=*(const u32x4*)(T.G+(size_t)lpos_to_row(b,p<LVALID?p:LVALID-1)*1024+h*64+ch*8);} }
  l_reg=pair_sum(l_reg);
  if(hi==0)wsf[32+r32]=l_reg;asm volatile("s_waitcnt lgkmcnt(0)":::"memory");
  float rli[16];
  #pragma unroll
  for(int r=0;r<16;++r)rli[r]=__builtin_amdgcn_rcpf(wsf[32+crow(r,hi)]);
  { bf16_t*stg=(bf16_t*)(shm+LDS_OST)+wid*2048;
    #pragma unroll
    for(int r=0;r<16;++r){const int orow=crow(r,hi);
      #pragma unroll
      for(int d0=0;d0<2;++d0)stg[orow*64+d0*32+r32]=f2bf_s(o[d0][r]*rli[r]);}
    asm volatile("s_waitcnt lgkmcnt(0)":::"memory");
    #pragma unroll
    for(int i=0;i<4;++i){const int row=i*8+(lane>>3),ch=lane&7; u32x4 v=*(const u32x4*)(stg+row*64+ch*8);
      const int p=q0+wid*QBLK+row; const bool ok=p<LVALID&&(p>=NMETA||b==0);
      const size_t off=(size_t)lpos_to_row(b,p<LVALID?p:LVALID-1)*1024+h*64+ch*8;
      if constexpr(MODE==0){ const u32x4 g=gpre[i];
        #pragma unroll
        for(int j=0;j<4;++j)v[j]=cvtpk_s(bf_lo(v[j])*fast_sigmoid(bf_lo(g[j])),bf_hi(v[j])*fast_sigmoid(bf_hi(g[j]))); }
      if(ok)*(u32x4*)(T.O+off)=v; } }
  asm volatile("s_waitcnt lgkmcnt(0)\n\ts_barrier":::"memory");
  #undef DMA_K
  #undef DMA_V
  #undef CMASK
  #undef START
  #undef RESC
  #undef ROT
}
template<int MODE> __device__ __forceinline__ bool attn_fixref_ok(const float*gq,const float*gk,const float*gk2,int lane){
  float a,b,c=0.f;
  if constexpr(MODE==0){ a=fabsf(gq[lane]); b=fabsf(gk[lane]); }
  else{ a=fmaxf(fabsf(gq[lane]),fabsf(gq[64+(lane&31)])); b=fabsf(gk[lane]); c=fabsf(gk2[lane&31]); }
  #pragma unroll
  for(int s=1;s<64;s<<=1){ a=fmaxf(a,__shfl_xor(a,s)); b=fmaxf(b,__shfl_xor(b,s)); c=fmaxf(c,__shfl_xor(c,s)); }
  const float bound=(MODE==0)?(0.125f*LOG2E*64.f)*a*b:LOG2E*a*sqrtf(64.f*b*b+32.f*c*c);
  const float bu=__uint_as_float(__builtin_amdgcn_readfirstlane(__float_as_uint(bound*1.05f+1.0f)));
  return bu<=60.f;
}
template<int NKS,int MODE,int THRL,bool FIXREF> __device__ __forceinline__ void attn_phase(char*lds,const AttnArgs&T,unsigned*qctr){
  volatile int*slot=(volatile int*)(lds+LDS_BYTES);
  const int tid=threadIdx.x;
  if(tid==0)*slot=(int)__hip_atomic_fetch_add(qctr,1u,__ATOMIC_RELAXED,__HIP_MEMORY_SCOPE_AGENT);
  __syncthreads();
  for(;;){ const int u=__builtin_amdgcn_readfirstlane(*slot); if(u>=64*33)break;
    int nxt=0; if(tid==0)nxt=(int)__hip_atomic_fetch_add(qctr,1u,__ATOMIC_RELAXED,__HIP_MEMORY_SCOPE_AGENT);
    __syncthreads();
    const int bh=u&63,qb=32-(u>>6);
    attn_unit<NKS,MODE,THRL,FIXREF>(bh>>4,bh&15,qb,T,lds);
    if(tid==0)*slot=nxt;
    __syncthreads(); }
}
#undef SBAR
#undef WAIT_BAR
#undef LDSV8
}
typedef GAS unsigned gu32;
typedef GAS unsigned long long gu64;
#define RLX_AGENT __ATOMIC_RELAXED, __HIP_MEMORY_SCOPE_AGENT
#define LDS_WAIT() asm volatile("s_waitcnt lgkmcnt(0)" ::: "memory")
#define VM_WAIT() asm volatile("s_waitcnt vmcnt(0)" ::: "memory")
#define XB_TMO      128
#define XB_XCNT(j)  (256  + 64 * (j))
#define XB_XSUB(j)  (1280 + 64 * (j))
#define XB_XGEN(j)  (2304 + 64 * (j))
#define XB_TOP      3328
#define XB_TOPGEN   3392
#define XCD_BAR_WORDS 3456
#define XB_SPIN_CAP (1u << 18)

__device__ __forceinline__ unsigned xb_ld(unsigned* p)              { return __hip_atomic_load(p, __ATOMIC_RELAXED, __HIP_MEMORY_SCOPE_AGENT); }
__device__ __forceinline__ unsigned xb_add(unsigned* p, unsigned v) { return __hip_atomic_fetch_add(p, v, __ATOMIC_RELAXED, __HIP_MEMORY_SCOPE_AGENT); }
__device__ __forceinline__ unsigned xb_xcc_id() { return (unsigned)__builtin_amdgcn_s_getreg((3 << 11) | 20) & 0xFu; }
#define XB_SPIN(cond, bar) do { unsigned _sp = 0; while (cond) { __builtin_amdgcn_s_sleep(1); \
    if ((++_sp & 255u) == 0u) { if (xb_ld(&(bar)[XB_TMO])) break; if (_sp > XB_SPIN_CAP) { atomicAdd(&(bar)[XB_TMO], 1u); break; } } } } while (0)

struct XcdBarrier {
    unsigned* bar; unsigned x;
    volatile LAS unsigned* st;
};

__device__ __forceinline__ XcdBarrier xcd_barrier_post(unsigned* bar, volatile LAS unsigned* st) {
    XcdBarrier b; b.bar = bar; b.x = xb_xcc_id(); b.st = st;
    if (threadIdx.x == 0) (void)xb_add(&bar[XB_XCNT(b.x)], 1u);
    return b;
}
__device__ __forceinline__ void xcd_barrier_complete(unsigned* bar, unsigned x, unsigned& nloc, unsigned& nx) {
    const unsigned G = gridDim.x * gridDim.y * gridDim.z;
    unsigned sum, cnt, mine, sp = 0u;
    for (;;) {
        sum = 0u; cnt = 0u; mine = 0u;
#pragma unroll
        for (unsigned j = 0; j < 16; ++j) { const unsigned c = xb_ld(&bar[XB_XCNT(j)]); sum += c; cnt += (c > 0u) ? 1u : 0u; mine = (j == x) ? c : mine; }
        if (sum == G) break;
        __builtin_amdgcn_s_sleep(1);
        if ((++sp & 255u) == 0u) { if (xb_ld(&bar[XB_TMO])) break; if (sp > XB_SPIN_CAP) { atomicAdd(&bar[XB_TMO], 1u); break; } }
    }
    nloc = mine > 0u ? mine : 1u; nx = cnt > 0u ? cnt : 1u;
}

__device__ __forceinline__ void xcd_barrier(const XcdBarrier& b) {
    asm volatile("s_waitcnt vmcnt(0)" ::: "memory");
    __syncthreads();
    if (threadIdx.x == 0) {
        unsigned* bar = b.bar;
        __builtin_amdgcn_s_waitcnt(0);
        unsigned nloc = b.st[0], nx = b.st[1];
        if (nloc == 0u) { xcd_barrier_complete(bar, b.x, nloc, nx); b.st[0] = nloc; b.st[1] = nx; }
        const unsigned old = xb_add(&bar[XB_XSUB(b.x)], 1u);
        const unsigned gen = old / nloc;
        if (old + 1u == (gen + 1u) * nloc) {
            __builtin_amdgcn_fence(__ATOMIC_RELEASE, "agent");
            asm volatile("s_waitcnt vmcnt(0)" ::: "memory");
            const unsigned og = xb_add(&bar[XB_TOP], 1u);
            const unsigned tg = og / nx;
            if (og + 1u == (tg + 1u) * nx) xb_add(&bar[XB_TOPGEN], 1u);
            else XB_SPIN(xb_ld(&bar[XB_TOPGEN]) == tg, bar);
            __builtin_amdgcn_fence(__ATOMIC_ACQUIRE, "agent");
            xb_add(&bar[XB_XGEN(b.x)], 1u);
            asm volatile("s_waitcnt vmcnt(0)" ::: "memory");
        } else {
            XB_SPIN(xb_ld(&bar[XB_XGEN(b.x)]) == gen, bar);
            __builtin_amdgcn_fence(__ATOMIC_ACQUIRE, "agent");
            asm volatile("s_waitcnt vmcnt(0)" ::: "memory");
        }
    }
    __syncthreads();
}

constexpr size_t MiB = 1u << 20;
constexpr size_t WS_CTL = 0, CTL_ZERO_BYTES = 1 * MiB;
constexpr size_t WS_HMETA = 1 * MiB;
constexpr size_t WS_ROPE = 2 * MiB;
constexpr size_t WS_ROUTE = 6 * MiB + 256 * 1024;
constexpr size_t WA = 8 * MiB;
constexpr size_t WA_FIN = WA, WA_FOUT = WA + 8 * MiB + 512 * 1024, WA_FFIN = WA_FOUT + 2 * MiB, WA_FFOUT = WA_FFIN + 11 * MiB;
constexpr size_t WB = 36 * MiB;
constexpr size_t WB_MIN = WB, WB_QUP = WB + 1 * MiB, WB_KVUP = WB + 2 * MiB, WB_MOUT = WB + 3 * MiB, WB_MOEIN = WB + 5 * MiB, WB_MOEOUT = WB_MOEIN + 44 * MiB;
constexpr size_t WS_H16 = 107 * MiB;
constexpr size_t WS_XN = 180 * MiB;
constexpr size_t ACT = 245 * MiB;
constexpr size_t F_QK = ACT, F_G = ACT + 129 * MiB, F_VP = ACT + 194 * MiB, F_KP = ACT + 260 * MiB, F_O = ACT + 343 * MiB, F_LF = ACT + 408 * MiB, F_CT = ACT + 411 * MiB, F_TS = ACT + 414 * MiB;
constexpr size_t D_HF = ACT;
constexpr size_t M_CRAW = ACT, M_CQ = ACT + 33 * MiB, M_CKV = ACT + 50 * MiB, M_KR = ACT + 67 * MiB, M_QRAW = ACT + 70 * MiB, M_KN = ACT + 167 * MiB, M_VP = ACT + 232 * MiB, M_KP = ACT + 298 * MiB, M_O = M_KN;
constexpr size_t E_XG = ACT, E_HF = ACT + 133 * MiB, E_Y = E_XG;
constexpr size_t WS_SSP = ACT + 499 * MiB;
constexpr size_t WS_SSPM = WS_HMETA + 65536;
constexpr size_t WS_NEED = ACT + 502 * MiB;
static_assert(WA_FFOUT + (size_t)1024 * 2816 * 2 <= WB && WB_MOEOUT + (size_t)8 * 1024 * 2816 <= WS_H16 && WS_H16 + (size_t)RPAD * 2048 <= WS_XN && WS_XN + (size_t)RPAD * 2048 <= ACT, "weights / xn map");
static_assert(F_QK + (size_t)RPAD * 4096 <= F_G && F_G + (size_t)RPAD * 2048 <= F_VP && F_VP + (size_t)LROWS * 2048 <= F_KP && F_KP + (size_t)LROWS * 2560 <= F_O && F_O + (size_t)RPAD * 2048 <= F_LF && F_LF + (size_t)RPAD * 64 <= F_CT && F_CT + (size_t)RPAD * 64 <= WS_SSP, "fox map");
static_assert(M_CRAW + (size_t)RPAD * 1024 <= M_CQ && M_CQ + (size_t)RPAD * 512 <= M_CKV && M_CKV + (size_t)RPAD * 512 <= M_KR && M_KR + (size_t)RPAD * 64 <= M_QRAW && M_QRAW + (size_t)RPAD * 3072 <= M_KN && M_KN + (size_t)RPAD * 2048 <= M_VP && M_VP + (size_t)LROWS * 2048 <= M_KP && M_KP + (size_t)LROWS * 3072 <= WS_SSP, "mla map");
static_assert(E_XG + (size_t)RG_MAX * 2048 <= E_HF && E_HF + (size_t)RG_MAX * DFF * 2 <= WS_SSP && D_HF + (size_t)RPAD * DFF * 2 <= WS_SSP && WS_SSP + (size_t)RPAD * 64 <= WS_NEED && WS_ROPE + (size_t)LROWS * 128 <= WS_ROUTE && WS_ROUTE + (size_t)RPAD * 32 <= WA, "moe / misc map");
constexpr int CW_BAR = 4096;
constexpr int CW_ATTQ = 12288;
constexpr int CW_CNT = 16384;

constexpr int RING_BYTES = 131072;
constexpr int MISC_OFF = RING_BYTES + 320;
constexpr int PT_OFF = MISC_OFF + 128;
constexpr int LDS_BYTES = 147456;
static_assert(attn_body::LDS_BYTES + 64 <= RING_BYTES, "attention LDS");

#ifndef CFG_F8_FFN0
#define CFG_F8_FFN0 0
#endif
#ifndef CFG_F8_FFN2
#define CFG_F8_FFN2 0
#endif
#ifndef CFG_F8_MOE1
#define CFG_F8_MOE1 1
#endif
#ifndef CFG_F8_MOE3
#define CFG_F8_MOE3 1
#endif
#ifndef TAIL_MASK
#define TAIL_MASK 0x7f
#endif
#define TAIL_ON(bit) ((TAIL_MASK >> (bit)) & 1)
static_assert(CFG_F8_MOE1 && CFG_F8_MOE3, "the workspace map assumes e4m3 expert weights in both MoE layers");
constexpr int NWAVES = 8, NTHREADS = 512;
constexpr int NPH = 19, N_PHASES = 2 * NPH + 1;

struct Args { const float* in[49]; float* out; unsigned char* ws; int ph_lo, ph_hi; };

struct Ctx { LAS unsigned char* lds; int tid, lane, wave, vcu, G, gw, NGW; };

__device__ __forceinline__ void zero_bytes(void* p, size_t nbytes, const Ctx& C) {
    const u32x4 z = {0u, 0u, 0u, 0u};
    for (size_t i = (size_t)(C.vcu * NTHREADS + C.tid); i < nbytes / 16; i += (size_t)C.G * NTHREADS) ((u32x4*)p)[i] = z;
}
__device__ __forceinline__ void tr_load(const float* W, int sp, int k0, int c0, int lane, f32x4 (&v)[8]) {
    const int n4 = (lane & 7) * 4, kr = lane >> 3;
#pragma unroll
    for (int i = 0; i < 8; ++i) v[i] = *(const f32x4*)(W + (size_t)(k0 + kr + 8 * i) * sp + c0 + n4);
}
template <bool F8> __device__ __forceinline__ void tr_fin(const f32x4 (&v)[8], int k0, void* WT, int dp, int drow0, LAS float* scr, int lane, const float* gain = nullptr) {
    { const int n4 = (lane & 7) * 4, kr = lane >> 3;
#pragma unroll
        for (int i = 0; i < 8; ++i) { LAS float* d = scr + (kr + 8 * i) * 33 + n4; d[0] = v[i].x; d[1] = v[i].y; d[2] = v[i].z; d[3] = v[i].w; }
    }
    LDS_WAIT(); asm volatile("" ::: "memory");
    const int c = lane & 7;
    f32x4 gA = {1.f, 1.f, 1.f, 1.f}, gB = gA; if (gain) { gA = *(const f32x4*)(gain + k0 + 8 * c); gB = *(const f32x4*)(gain + k0 + 8 * c + 4); }
#pragma unroll
    for (int j = 0; j < 4; ++j) { const int n = (lane >> 3) + 8 * j; const LAS float* s = scr + (8 * c) * 33 + n;
        if constexpr (F8) { u32x2 o; o.x = pack4_fp8(s[0 * 33] * F8_SW, s[1 * 33] * F8_SW, s[2 * 33] * F8_SW, s[3 * 33] * F8_SW); o.y = pack4_fp8(s[4 * 33] * F8_SW, s[5 * 33] * F8_SW, s[6 * 33] * F8_SW, s[7 * 33] * F8_SW);
            *(u32x2*)((unsigned char*)WT + (size_t)(drow0 + n) * dp + k0 + 8 * c) = o; }
        else { u32x4 o; o.x = cvt_pk_bf16(s[0 * 33] * gA[0], s[1 * 33] * gA[1]); o.y = cvt_pk_bf16(s[2 * 33] * gA[2], s[3 * 33] * gA[3]); o.z = cvt_pk_bf16(s[4 * 33] * gB[0], s[5 * 33] * gB[1]); o.w = cvt_pk_bf16(s[6 * 33] * gB[2], s[7 * 33] * gB[3]);
            *(u32x4*)((bf16_t*)WT + (size_t)(drow0 + n) * dp + k0 + 8 * c) = o; } }
    LDS_WAIT(); asm volatile("" ::: "memory");
}
template <bool F8> __device__ __forceinline__ void tr_item(const float* W, int sp, int k0, int c0, void* WT, int dp, int drow0, LAS float* scr, int lane, const float* gain = nullptr) {
    f32x4 v[8]; tr_load(W, sp, k0, c0, lane, v); tr_fin<F8>(v, k0, WT, dp, drow0, scr, lane, gain);
}
template <int KIND> __device__ __forceinline__ int dst_row(int c) {
    if (KIND == 1) { const int up = c >= DFF, i = up ? c - DFF : c; return (i >> 7) * 256 + up * 128 + (i & 127); }
    if (KIND == 2) { const int h = c >> 7, j = c & 127; return j < 64 ? (h >> 2) * 256 + (j >> 5) * 128 + (h & 3) * 32 + (j & 31) : 1024 + h * 64 + (j - 64); }
    if (KIND == 3) { if (c < 1024 || c >= 2048) return c; const int h = (c - 1024) >> 6, j = c & 63; return 1024 + (h >> 2) * 256 + (j >> 5) * 128 + (h & 3) * 32 + (j & 31); }
    return c;
}
template <int KIND, bool F8 = false> __device__ __forceinline__ void tr_mat_item(const float* W, int ncols, int sp, void* WT, int dp, int it, LAS float* scr, int lane, const float* gain = nullptr) {
    const int nblk = ncols / 32, kb = it / nblk, nb = it % nblk;
    tr_item<F8>(W, sp, 64 * kb, 32 * nb, WT, dp, dst_row<KIND>(32 * nb), scr, lane, gain);
}
__device__ __forceinline__ void tr_mat_load(const float* W, int ncols, int sp, int it, int lane, f32x4 (&v)[8]) { const int nblk = ncols / 32, kb = it / nblk, nb = it % nblk; tr_load(W, sp, 64 * kb, 32 * nb, lane, v); }
template <int KIND, bool F8 = false> __device__ __forceinline__ void tr_mat_fin(const f32x4 (&v)[8], int ncols, void* WT, int dp, int it, LAS float* scr, int lane, const float* gain = nullptr) {
    const int nblk = ncols / 32, kb = it / nblk, nb = it % nblk; tr_fin<F8>(v, 64 * kb, WT, dp, dst_row<KIND>(32 * nb), scr, lane, gain);
}

__device__ __forceinline__ void load_row(const float* src, f32x4 (&v)[4], int lane) {
    const GAS f32x4* p = (const GAS f32x4*)src + lane;
#pragma unroll
    for (int j = 0; j < 4; ++j) v[j] = p[64 * j];
}
__device__ __forceinline__ void store_row(float* dst, const f32x4 (&v)[4], int lane) {
    GAS f32x4* p = (GAS f32x4*)dst + lane;
#pragma unroll
    for (int j = 0; j < 4; ++j) p[64 * j] = v[j];
}
__device__ __forceinline__ void load_row16(const bf16_t* src, f32x4 (&v)[4], int lane) {
    const GAS u32x2* p = (const GAS u32x2*)src + lane;
#pragma unroll
    for (int j = 0; j < 4; ++j) { const u32x2 w = p[64 * j]; v[j] = (f32x4){bf_lo(w.x), bf_hi(w.x), bf_lo(w.y), bf_hi(w.y)}; }
}
__device__ __forceinline__ void store_row16(bf16_t* dst, const f32x4 (&v)[4], int lane) {
    GAS u32x2* p = (GAS u32x2*)dst + lane;
#pragma unroll
    for (int j = 0; j < 4; ++j) { u32x2 w; w.x = cvt_pk_bf16(v[j].x, v[j].y); w.y = cvt_pk_bf16(v[j].z, v[j].w); p[64 * j] = w; }
}
__device__ __forceinline__ void load_gain(const float* g, f32x4 (&gv)[4], int lane) {
#pragma unroll
    for (int j = 0; j < 4; ++j) gv[j] = *(const f32x4*)(g + 4 * lane + 256 * j);
}
template <bool F8 = false> __device__ __forceinline__ void norm_row(f32x4 (&v)[4], const f32x4 (&gv)[4], void* dst, int lane) {
    float s = 0.f;
#pragma unroll
    for (int j = 0; j < 4; ++j) s += (v[j].x * v[j].x + v[j].y * v[j].y) + (v[j].z * v[j].z + v[j].w * v[j].w);
    const float rn = __builtin_amdgcn_rsqf(wave_sum(s) * (1.0f / 1024.0f) + EPSN);
#pragma unroll
    for (int j = 0; j < 4; ++j) { v[j] = v[j] * rn * gv[j];
        if constexpr (F8) ((GAS unsigned*)dst)[lane + 64 * j] = pack4_fp8(v[j].x * F8_SX, v[j].y * F8_SX, v[j].z * F8_SX, v[j].w * F8_SX);
        else { u32x2 w; w.x = cvt_pk_bf16(v[j].x, v[j].y); w.y = cvt_pk_bf16(v[j].z, v[j].w); ((GAS u32x2*)dst)[lane + 64 * j] = w; } }
}
__device__ __forceinline__ void moe_combine_row(f32x4 (&v)[4], const u32x4 ra, const u32x2 rb, const int* roff, const bf16_t* Y, int lane) {
    int r0 = 0, r1 = 0;
#pragma unroll
    for (int e = 0; e < 8; ++e) { r0 = (int)ra.x == e ? roff[e] : r0; r1 = (int)ra.y == e ? roff[e] : r1; }
    r0 += (int)ra.z; r1 += (int)ra.w; const float w0 = __uint_as_float(rb.x), w1 = __uint_as_float(rb.y);
    const GAS u32x2* y0 = (const GAS u32x2*)(Y + (size_t)r0 * 1024) + lane; const GAS u32x2* y1 = (const GAS u32x2*)(Y + (size_t)r1 * 1024) + lane;
#pragma unroll
    for (int j = 0; j < 4; ++j) { const u32x2 a = y0[64 * j], b = y1[64 * j];
        v[j].x += w0 * bf_lo(a.x) + w1 * bf_lo(b.x); v[j].y += w0 * bf_hi(a.x) + w1 * bf_hi(b.x); v[j].z += w0 * bf_lo(a.y) + w1 * bf_lo(b.y); v[j].w += w0 * bf_hi(a.y) + w1 * bf_hi(b.y); }
}
__device__ __forceinline__ int moe_offsets(const gu32* cnt, int (&toff)[9]) {
    int t = 0;
#pragma unroll
    for (int e = 0; e < 8; ++e) { toff[e] = t; const unsigned c = __hip_atomic_load(cnt + 64 * e, RLX_AGENT); t += (int)((c + 255u) >> 8); }
    toff[8] = t; return t;
}

template <int MODE> __device__ __forceinline__ void kprep_row(const u32x4 a, const u32x4 b, const u32x4 krt, const f32x4 (&g)[4], bf16_t* KPb, int lrow0, int nd, float cval, int lane) {
    constexpr int DKP = MODE == 0 ? 80 : 96, KPITCH = 16 * DKP;
    const int h = lane >> 2, q4 = lane & 3;
    float x[16];
#pragma unroll
    for (int j = 0; j < 4; ++j) { x[2 * j] = bf_lo(a[j]); x[2 * j + 1] = bf_hi(a[j]); x[8 + 2 * j] = bf_lo(b[j]); x[8 + 2 * j + 1] = bf_hi(b[j]); }
    float ss = 0.f;
#pragma unroll
    for (int j = 0; j < 16; ++j) ss += x[j] * x[j];
    ss += __shfl_xor(ss, 1); ss += __shfl_xor(ss, 2);
    const float rn = 1.0f / sqrtf(ss * (1.0f / 64.0f) + EPSN);
    u32x4 o0, o1;
#pragma unroll
    for (int j = 0; j < 4; ++j) { const int i0 = 2 * j, i1 = 8 + 2 * j;
        o0[j] = cvt_pk_bf16(x[i0] * rn * g[i0 >> 2][i0 & 3], x[i0 + 1] * rn * g[(i0 + 1) >> 2][(i0 + 1) & 3]);
        o1[j] = cvt_pk_bf16(x[i1] * rn * g[i1 >> 2][i1 & 3], x[i1 + 1] * rn * g[(i1 + 1) >> 2][(i1 + 1) & 3]); }
    u32x4 tl = {0u, 0u, 0u, 0u}; bool has_tail;
    if (MODE == 0) {
        has_tail = q4 < 2;
        if (q4 == 0) { const float ng = -cval * LOG2E; const bf16_t h1 = f2bf(ng); const float f1 = bf2f(h1); const bf16_t h2 = f2bf(ng - f1); const float f2 = bf2f(h2); const bf16_t h3 = f2bf(ng - f1 - f2);
            tl.x = (unsigned)h1 | ((unsigned)h2 << 16); tl.y = (unsigned)h3 | 0x3F800000u; tl.z = 0x3F803F80u; tl.w = 0u; }
    } else { has_tail = true; tl = krt; }
    for (int d = 0; d < nd; ++d) { bf16_t* base = KPb + (size_t)(lrow0 + d * LP) * KPITCH + h * DKP;
        *(u32x4*)(base + 16 * q4) = o0; *(u32x4*)(base + 16 * q4 + 8) = o1;
        if (has_tail) *(u32x4*)(base + 64 + 8 * q4) = tl; }
}

__device__ __forceinline__ f32x4 tail_tile(const bf16_t* A16, int lda, const bf16_t* B16, int ldb, int K, int lane) {
    const int fr = lane & 15, fq = lane >> 4;
    const bf16_t* ap = A16 + (size_t)fr * lda + 8 * fq; const bf16_t* bp = B16 + (size_t)fr * ldb + 8 * fq;
    f32x4 acc = {0.f, 0.f, 0.f, 0.f};
    for (int k = 0; k < K; k += 256) { bf16x8 a[8], b[8];
#pragma unroll
        for (int i = 0; i < 8; ++i) { a[i] = *(const bf16x8*)(ap + k + 32 * i); b[i] = *(const bf16x8*)(bp + k + 32 * i); }
#pragma unroll
        for (int i = 0; i < 8; ++i) acc = __builtin_amdgcn_mfma_f32_16x16x32_bf16(b[i], a[i], acc, 0, 0, 0); }
    return acc;
}
template <int DKP> __device__ __forceinline__ void tail_khead(const bf16_t* A16, int lda, const bf16_t* Bhead, int K, const float* gk, bf16_t* Kp, int head, int lane) {
    const int fr = lane & 15, fq = lane >> 4; f32x4 v[4] = {}; float ss = 0.f;
    {
        const bf16_t* ap = A16 + (size_t)fr * lda + 8 * fq; const bf16_t* bp = Bhead + (size_t)fr * K + 8 * fq;
        for (int k = 0; k < K; k += 256) { bf16x8 a[8], b[4][8];
#pragma unroll
            for (int i = 0; i < 8; ++i) a[i] = *(const bf16x8*)(ap + k + 32 * i);
#pragma unroll
            for (int ti = 0; ti < 4; ++ti)
#pragma unroll
                for (int i = 0; i < 8; ++i) b[ti][i] = *(const bf16x8*)(bp + (size_t)((ti >> 1) * 128 + (ti & 1) * 16) * K + k + 32 * i);
#pragma unroll
            for (int ti = 0; ti < 4; ++ti)
#pragma unroll
                for (int i = 0; i < 8; ++i) v[ti] = __builtin_amdgcn_mfma_f32_16x16x32_bf16(b[ti][i], a[i], v[ti], 0, 0, 0); }
    }
#pragma unroll
    for (int ti = 0; ti < 4; ++ti) ss += (v[ti][0] * v[ti][0] + v[ti][1] * v[ti][1]) + (v[ti][2] * v[ti][2] + v[ti][3] * v[ti][3]);
    ss += __shfl_xor(ss, 16); ss += __shfl_xor(ss, 32);
    const float rn = __builtin_amdgcn_rsqf(ss * (1.0f / 64.0f) + EPSN);
#pragma unroll
    for (int ti = 0; ti < 4; ++ti) { const f32x4 g = *(const f32x4*)(gk + 16 * ti + 4 * fq); const f32x4 o = v[ti] * rn * g; u32x2 w; w.x = attn_body::cvtpk_s(o[0], o[1]); w.y = attn_body::cvtpk_s(o[2], o[3]);
        for (int b = 0; b < NB; ++b) *(u32x2*)(Kp + (size_t)(b * LP + fr) * (16 * DKP) + head * DKP + 16 * ti + 4 * fq) = w; }
}
__device__ __forceinline__ u32x2 pack4_bf16(const f32x4 v) { u32x2 w; w.x = attn_body::cvtpk_s(v[0], v[1]); w.y = attn_body::cvtpk_s(v[2], v[3]); return w; }
__device__ __forceinline__ const void* ldptr(LAS unsigned char* pt, int k) {
    const LAS unsigned* p = (const LAS unsigned*)pt + 2 * k; const unsigned lo = p[0], hi = p[1];
    return (const void*)(const GAS void*)(((unsigned long long)(unsigned)__builtin_amdgcn_readfirstlane((int)hi) << 32) | (unsigned)__builtin_amdgcn_readfirstlane((int)lo));
}
__global__ void __launch_bounds__(NTHREADS, 2) trunk_fwd(Args args) {
    extern __shared__ __attribute__((aligned(16))) unsigned char lds_raw[];
#define MAKE_CTX(C) Ctx C; { int t_ = threadIdx.x; asm volatile("" : "+v"(t_)); C.lds = (LAS unsigned char*)lds_raw; C.tid = t_; C.lane = t_ & 63; C.wave = __builtin_amdgcn_readfirstlane(t_ >> 6); \
        C.G = gridDim.x; { const int bx = blockIdx.x; C.vcu = (C.G % 8 == 0) ? (bx % 8) * (C.G / 8) + bx / 8 : bx; } C.gw = C.vcu * NWAVES + C.wave; C.NGW = C.G * NWAVES; }
    MAKE_CTX(C0);
    volatile LAS unsigned* MISC = (volatile LAS unsigned*)(C0.lds + MISC_OFF);
    for (int u = C0.tid; u < (LDS_BYTES - RING_BYTES) / 4; u += NTHREADS) ((LAS unsigned*)(C0.lds + RING_BYTES))[u] = 0u;
    __syncthreads();
    if (C0.tid < 51) { const unsigned long long v = C0.tid < 49 ? (unsigned long long)args.in[C0.tid] : (C0.tid == 49 ? (unsigned long long)args.out : (unsigned long long)args.ws); ((LAS unsigned long long*)(C0.lds + PT_OFF))[C0.tid] = v; }
    __syncthreads();
    unsigned char* ws0 = (unsigned char*)ldptr(C0.lds + PT_OFF, 50);
    gu32* ctl0 = (gu32*)(ws0 + WS_CTL);
#define PHASE_LOCALS MAKE_CTX(C); const int tw = C.wave * C.G + C.vcu, fr_ = C.lane & 15, fq_ = C.lane >> 4; (void)tw; (void)fr_; (void)fq_; LAS float* scr = (LAS float*)(C.lds + C.wave * 16384); (void)scr; unsigned long long wsi_ = (unsigned long long)ldptr(C.lds + PT_OFF, 50); asm volatile("" : "+s"(wsi_)); unsigned char* ws = (unsigned char*)(GAS unsigned char*)wsi_; gu32* ctl = (gu32*)(ws + WS_CTL); float* hreal = (float*)ldptr(C.lds + PT_OFF, 49); float* hmeta = (float*)(ws + WS_HMETA); float* rope = (float*)(ws + WS_ROPE); unsigned* route = (unsigned*)(ws + WS_ROUTE); bf16_t* XN = (bf16_t*)(ws + WS_XN); bf16_t* H16 = (bf16_t*)(ws + WS_H16); (void)H16; const gu32* cnt_prev = ctl + CW_CNT + (lp > 0 ? (lp - 1) * 1024 : 0); gu32* cnt = ctl + CW_CNT + lp * 1024; (void)hreal; (void)hmeta; (void)rope; (void)route; (void)XN; (void)cnt_prev; (void)cnt;
    XcdBarrier bar = xcd_barrier_post((unsigned*)(ctl0 + CW_BAR), MISC + 8);
    const int lo = args.ph_lo, hi = args.ph_hi;
#define IN(k) (lo <= (k) && (k) < hi)
#define SEAM(k) do { if (IN(k) && IN((k) + 1)) xcd_barrier(bar); } while (0)
#ifdef ONLY_PHASE
#define PHEN(c) ((c) == ONLY_PHASE)
#else
#define PHEN(c) true
#endif
#define INP(c) (PHEN(c) && IN(P0 + (c)))
#define SEAMP(c) SEAM(P0 + (c))

#define X_IN ((const float*)ldptr(C.lds + PT_OFF, 0))
#define POS_IN ((const int*)ldptr(C.lds + PT_OFF, 1))
#define META_IN ((const float*)ldptr(C.lds + PT_OFF, 2))
#define WP(k) ((const float*)ldptr(C.lds + PT_OFF, 3 + lp * 23 + (k)))
#define LOAD_H(m, v) do { if ((m) < NREAL) load_row16(H16 + (size_t)(m) * 1024, v, C.lane); else load_row(hmeta + (size_t)((m) - NREAL) * 1024, v, C.lane); } while (0)
#define STORE_H(m, v) do { if ((m) < NREAL) store_row16(H16 + (size_t)(m) * 1024, v, C.lane); else store_row(hmeta + (size_t)((m) - NREAL) * 1024, v, C.lane); } while (0)

    for (int lp = 0; lp < 2; ++lp) {
        const int P0 = lp * NPH;
        const bool f8ffn = lp ? (bool)CFG_F8_FFN2 : (bool)CFG_F8_FFN0, f8moe = lp ? (bool)CFG_F8_MOE3 : (bool)CFG_F8_MOE1;


        if (INP(0)) { PHASE_LOCALS
            if (lp == 0) {
                const int* positions = POS_IN;
                for (int i = C.vcu * NTHREADS + C.tid; i < LROWS * 16; i += C.G * NTHREADS) { const int lr = i >> 4, f = i & 15, b = lr / LP, pos = lr % LP;
                    const int p = pos < NMETA ? pos : (pos < LVALID ? positions[b * SEQ + pos - NMETA] : 0);
                    const float ang = (float)p * powf(10000.0f, -(float)(2 * f) / 32.0f);
                    rope[(size_t)lr * 32 + f] = cosf(ang); rope[(size_t)lr * 32 + 16 + f] = sinf(ang); }
                zero_bytes(XN + (size_t)NROWS * 1024, (size_t)(RPAD - NROWS) * 2048, C);
            }
            zero_bytes(ws + WA_FIN + (size_t)4112 * 2048, (size_t)240 * 2048, C);
            for (int b = 0; b < NB; ++b) { zero_bytes(ws + F_VP + (size_t)(b * LP + LVALID) * 2048, (size_t)(LP - LVALID) * 2048, C); zero_bytes(ws + F_KP + (size_t)(b * LP + LVALID) * 2560, (size_t)(LP - LVALID) * 2560, C); }
            {
                constexpr int I1 = 16 * 128, I2 = 16 * 32, I3 = 16 * 176, I4 = 44 * 32, I5 = 16, NIT = I1 + I2 + I3 + I4 + I5;
                for (int it = C.gw; it < NIT; it += C.NGW) { int r = it;
                    if (r < I1) { tr_mat_item<3>(WP(1), 4096, 4112, (bf16_t*)(ws + WA_FIN), 1024, r, scr, C.lane); continue; } r -= I1;
                    if (r < I2) { tr_mat_item<0>(WP(5), 1024, 1024, (bf16_t*)(ws + WA_FOUT), 1024, r, scr, C.lane); continue; } r -= I2;
                    if (r < I3) { tr_mat_item<1>(WP(7), 5632, 5632, ws + WA_FFIN, 1024, r, scr, C.lane, WP(6)); continue; } r -= I3;
                    if (r < I4) { if (f8ffn) tr_mat_item<0, true>(WP(8), 1024, 1024, ws + WA_FFOUT, 2816, r, scr, C.lane); else tr_mat_item<0>(WP(8), 1024, 1024, ws + WA_FFOUT, 2816, r, scr, C.lane); continue; } r -= I4;
                    { const int k = r * 64 + C.lane; const float* s = WP(1) + (size_t)k * 4112 + 4096; bf16_t* d = (bf16_t*)(ws + WA_FIN) + (size_t)4096 * 1024 + k;
#pragma unroll
                      for (int j = 0; j < 16; ++j) d[(size_t)j * 1024] = f2bf(s[j]); }
                }
            }
            zero_bytes(ws + WB_MIN + (size_t)416 * 2048, (size_t)96 * 2048, C);
            for (int i = C.vcu * NTHREADS + C.tid; i < 2048 * 16; i += C.G * NTHREADS) *(u32x4*)((bf16_t*)(ws + WB_KVUP) + (size_t)(i >> 4) * 256 + 128 + (i & 15) * 8) = (u32x4){0u, 0u, 0u, 0u};
            {
                constexpr int J1 = 16 * 13, J2 = 4 * 48, J3 = 2 * 64, J4 = 16 * 32, J5 = 8 * 2816, J6 = 8 * 1408, NIT = J1 + J2 + J3 + J4 + J5 + J6;
#define JSRC(itx, vx) do { int r_ = (itx); \
                    if (r_ < J1) tr_mat_load(WP(10), 416, 416, r_, C.lane, vx); else { r_ -= J1; \
                    if (r_ < J2) tr_mat_load(WP(12), 1536, 1536, r_, C.lane, vx); else { r_ -= J2; \
                    if (r_ < J3) tr_mat_load(WP(14), 2048, 2048, r_, C.lane, vx); else { r_ -= J3; \
                    if (r_ < J4) tr_mat_load(WP(18), 1024, 1024, r_, C.lane, vx); else { r_ -= J4; \
                    if (r_ < J5) tr_mat_load(WP(21) + (size_t)(r_ / 2816) * 1024 * 5632, 5632, 5632, r_ % 2816, C.lane, vx); else { r_ -= J5; \
                    tr_mat_load(WP(22) + (size_t)(r_ / 1408) * DFF * 1024, 1024, 1024, r_ % 1408, C.lane, vx); } } } } } } while (0)
                f32x4 v[8] = {}; if (C.gw < NIT) JSRC(C.gw, v);
                for (int it = C.gw; it < NIT; it += C.NGW) { int r = it; f32x4 nv[8] = {v[0], v[1], v[2], v[3], v[4], v[5], v[6], v[7]};
                    if (it + C.NGW < NIT) JSRC(it + C.NGW, nv);
                    if (r < J1) tr_mat_fin<0>(v, 416, (bf16_t*)(ws + WB_MIN), 1024, r, scr, C.lane, WP(9));
                    else { r -= J1;
                    if (r < J2) tr_mat_fin<0>(v, 1536, (bf16_t*)(ws + WB_QUP), 256, r, scr, C.lane);
                    else { r -= J2;
                    if (r < J3) tr_mat_fin<2>(v, 2048, (bf16_t*)(ws + WB_KVUP), 256, r, scr, C.lane);
                    else { r -= J3;
                    if (r < J4) tr_mat_fin<0>(v, 1024, (bf16_t*)(ws + WB_MOUT), 1024, r, scr, C.lane);
                    else { r -= J4;
                    if (r < J5) { const int e = r / 2816; if (f8moe) tr_mat_fin<1, true>(v, 5632, ws + WB_MOEIN + (size_t)e * 5632 * 1024, 1024, r % 2816, scr, C.lane); else tr_mat_fin<1>(v, 5632, ws + WB_MOEIN + (size_t)e * 5632 * 1024 * 2, 1024, r % 2816, scr, C.lane); }
                    else { r -= J5; const int e = r / 1408; if (f8moe) tr_mat_fin<0, true>(v, 1024, ws + WB_MOEOUT + (size_t)e * 1024 * DFF, DFF, r % 1408, scr, C.lane); else tr_mat_fin<0>(v, 1024, ws + WB_MOEOUT + (size_t)e * 1024 * DFF * 2, DFF, r % 1408, scr, C.lane); } } } } }
#pragma unroll
                    for (int i = 0; i < 8; ++i) v[i] = nv[i];
                }
#undef JSRC
            }
            {
                f32x4 gv[4]; load_gain(WP(0), gv, C.lane); const float* xin = X_IN; const float* metain = META_IN;
                int roff[9] = {0, 0, 0, 0, 0, 0, 0, 0, 0}; if (lp > 0) moe_offsets(cnt_prev, roff);
#pragma unroll
                for (int e = 0; e < 9; ++e) roff[e] *= 256;
#define ROW0_LOAD(m, v) do { if (lp == 0) load_row((m) < NREAL ? xin + (size_t)(m) * 1024 : metain + (size_t)((m) - NREAL) * 1024, v, C.lane); else LOAD_H(m, v); } while (0)
                f32x4 v[4] = {}; u32x4 ra = {0u, 0u, 0u, 0u}; u32x2 rb = {0u, 0u}; int m = C.gw;
                if (m < NROWS) { ROW0_LOAD(m, v); if (lp > 0) { ra = *(const u32x4*)(route + (size_t)m * 8); rb = *(const u32x2*)(route + (size_t)m * 8 + 4); } }
                for (; m < NROWS; m += C.NGW) { const int mn = m + C.NGW; f32x4 nv[4] = {v[0], v[1], v[2], v[3]}; u32x4 nra = {0u, 0u, 0u, 0u}; u32x2 nrb = {0u, 0u};
                    if (mn < NROWS) { ROW0_LOAD(mn, nv); if (lp > 0) { nra = *(const u32x4*)(route + (size_t)mn * 8); nrb = *(const u32x2*)(route + (size_t)mn * 8 + 4); } }
                    if (lp > 0) { moe_combine_row(v, ra, rb, roff, (const bf16_t*)(ws + E_Y), C.lane); STORE_H(m, v); } else if (m < NREAL) store_row16(H16 + (size_t)m * 1024, v, C.lane);
                    norm_row(v, gv, XN + (size_t)m * 1024, C.lane);
#pragma unroll
                    for (int j = 0; j < 4; ++j) v[j] = nv[j];
                    ra = nra; rb = nrb; }
#undef ROW0_LOAD
            }
        }
        SEAMP(0);
        if (INP(1)) { PHASE_LOCALS
            if (TAIL_ON(0)) {
                const bf16_t* A16 = XN + (size_t)NREAL * 1024; const bf16_t* Bt = (const bf16_t*)(ws + WA_FIN); bf16_t* QK = (bf16_t*)(ws + F_QK); bf16_t* Vp = (bf16_t*)(ws + F_VP); bf16_t* Gt = (bf16_t*)(ws + F_G); float* lf = (float*)(ws + F_LF); float* tsum = (float*)(ws + F_TS);
                for (int tt = ((C.wave + 7) & 7) * C.G + C.vcu; tt < 208; tt += C.NGW) {
                    if (tt >= 64 && tt < 80) { const int hh = tt - 64; tail_khead<80>(A16, 1024, Bt + (size_t)(1024 + (hh >> 2) * 256 + (hh & 3) * 32) * 1024, 1024, WP(4), (bf16_t*)(ws + F_KP), hh, C.lane); continue; }
                    const int t = tt < 64 ? tt : tt + 48;
                    const u32x2 w = pack4_bf16(tail_tile(A16, 1024, Bt + (size_t)16 * t * 1024, 1024, 1024, C.lane)); const int col = 16 * t + 4 * fq_;
                    if (t < 64) *(u32x2*)(QK + (size_t)(NREAL + fr_) * 2048 + col) = w;
                    else if (t < 192) { for (int b = 0; b < NB; ++b) *(u32x2*)(Vp + (size_t)(b * LP + fr_) * 1024 + col - 2048) = w; }
                    else *(u32x2*)(Gt + (size_t)(NREAL + fr_) * 1024 + col - 3072) = w; }
                const f32x4 bv = *(const f32x4*)(WP(2) + 4 * fq_);
                for (int t = tw; t < NROWS / 16; t += C.NGW) { const f32x4 z = tail_tile(XN + (size_t)16 * t * 1024, 1024, Bt + (size_t)4096 * 1024, 1024, 1024, C.lane) + bv; f32x4 o;
#pragma unroll
                    for (int j = 0; j < 4; ++j) o[j] = fminf(z[j], 0.f) - log1pf(expf(-fabsf(z[j])));
                    *(f32x4*)(lf + (size_t)(16 * t + fr_) * 16 + 4 * fq_) = o;
#pragma unroll
                    for (int j = 0; j < 4; ++j) { float s = o[j]; s += __shfl_xor(s, 1); s += __shfl_xor(s, 2); s += __shfl_xor(s, 4); s += __shfl_xor(s, 8); o[j] = s; }
                    if (fr_ == 0) *(f32x4*)(tsum + (size_t)t * 16 + 4 * fq_) = o; }
            }
            constexpr int MR = TAIL_ON(0) ? NREAL : RPAD, NC = TAIL_ON(0) ? 4096 : 4352;
            pg8::Gemm g{XN, (const bf16_t*)(ws + WA_FIN), MR, NC, 1024}; pg8::StaticOrder S; S.init(MR, NC, C.G, (int)blockIdx.x);
            pg8::EpiFoxIn E{(bf16_t*)(ws + F_QK), (bf16_t*)(ws + F_VP), (bf16_t*)(ws + F_G), (float*)(ws + F_LF), WP(2), (bf16_t*)(ws + F_KP), WP(4)};
            pg8::gemm_phase<pg8::EpiFoxIn, pg8::StaticOrder, true, true>(C.lds, g, S, E);
        }
        SEAMP(1);
        if (INP(2)) { PHASE_LOCALS
            const float* lf = (const float*)(ws + F_LF); const float* tsum = (const float*)(ws + F_TS); float* ctab = (float*)(ws + F_CT); const bf16_t* QK = (const bf16_t*)(ws + F_QK); bf16_t* KPb = (bf16_t*)(ws + F_KP);
            LAS float* red = (LAS float*)C.lds; LAS float* pre = red + 512; LAS float* cs = pre + 16; LAS float* seg = cs + 2048;
            const int hh = C.tid & 15, sg = C.tid >> 4;
            for (int ci = C.vcu; ci < 257; ci += C.G) {
                const bool meta = ci == 256; const int nr = meta ? NMETA : 128, r0 = meta ? NREAL : ci * 128, b = ci >> 6, t0 = (ci & 63) * 128;
                float acc = 0.f;
                if (!meta) { const float* base = tsum + (size_t)b * (SEQ / 16) * 16; for (int t = sg; t < t0 / 16; t += 32) acc += base[(size_t)t * 16 + hh];
                    if (sg == 0) acc += tsum[(size_t)(NREAL / 16) * 16 + hh]; }
                red[sg * 16 + hh] = acc;
                for (int idx = C.tid; idx < nr * 16; idx += NTHREADS) cs[idx] = lf[(size_t)r0 * 16 + idx];
                __syncthreads();
                if (C.tid < 16) { float s = 0.f; for (int k = 0; k < 32; ++k) s += red[k * 16 + C.tid]; pre[C.tid] = s; }
                { float s = 0.f; for (int q = 0; q < 4; ++q) { const int row = sg * 4 + q; if (row < nr) s += cs[row * 16 + hh]; } seg[sg * 16 + hh] = s; }
                __syncthreads();
                float cv[4]; { float p = pre[hh]; for (int k = 0; k < sg; ++k) p += seg[k * 16 + hh]; for (int q = 0; q < 4; ++q) { const int row = sg * 4 + q; if (row < nr) p += cs[row * 16 + hh]; cv[q] = p; } }
                __syncthreads();
                for (int q = 0; q < 4; ++q) { const int row = sg * 4 + q; if (row < nr) { cs[row * 16 + hh] = cv[q]; ctab[(size_t)(r0 + row) * 16 + hh] = cv[q]; } }
                __syncthreads();
                const int rpw = nr / 8;
                for (int rr = 0; rr < rpw; ++rr) { const int row = C.wave * rpw + rr, r = r0 + row;
                    if (C.lane < 32) { const int hd = C.lane >> 1; u32x4 tl = {0u, 0u, 0u, 0u};
                        if ((C.lane & 1) == 0) { const float ng = -cs[row * 16 + hd] * LOG2E; const bf16_t h1 = f2bf(ng); const float f1 = bf2f(h1); const bf16_t h2 = f2bf(ng - f1); const float f2 = bf2f(h2); const bf16_t h3 = f2bf(ng - f1 - f2);
                            tl.x = (unsigned)h1 | ((unsigned)h2 << 16); tl.y = (unsigned)h3 | 0x3F800000u; tl.z = 0x3F803F80u; }
                        const int lrow0 = meta ? row : row_to_lrow(r), nd = meta ? NB : 1;
                        for (int d = 0; d < nd; ++d) *(u32x4*)(KPb + (size_t)(lrow0 + d * LP) * 1280 + hd * 80 + 64 + 8 * (C.lane & 1)) = tl; } }
                __syncthreads();
            }
        }
        SEAMP(2);
        if (INP(3)) { PHASE_LOCALS
            const attn_body::AttnArgs AT{(const bf16_t*)(ws + F_QK), (const bf16_t*)(ws + F_KP), (const bf16_t*)(ws + F_VP), (bf16_t*)(ws + F_O), (const bf16_t*)(ws + F_G), WP(3), (const float*)(ws + F_CT), nullptr};
            if (attn_body::attn_fixref_ok<0>(WP(3), WP(4), nullptr, C.lane)) attn_body::attn_phase<5, 0, 8, true>((char*)lds_raw, AT, (unsigned*)(ctl + CW_ATTQ + (2 * lp) * 64));
            else attn_body::attn_phase<5, 0, 8, false>((char*)lds_raw, AT, (unsigned*)(ctl + CW_ATTQ + (2 * lp) * 64));
        }
        SEAMP(3);
        if (INP(4)) { PHASE_LOCALS
            if (TAIL_ON(1)) { const float* mi = lp == 0 ? META_IN : hmeta;
              for (int t = tw; t < 64; t += C.NGW) { const f32x4 a = tail_tile((const bf16_t*)(ws + F_O) + (size_t)NREAL * 1024, 1024, (const bf16_t*)(ws + WA_FOUT) + (size_t)16 * t * 1024, 1024, 1024, C.lane);
                  const size_t off = (size_t)fr_ * 1024 + 16 * t + 4 * fq_; const f32x4 o = *(const f32x4*)(mi + off) + a; *(f32x4*)(hmeta + off) = o;
                  *(u32x2*)(H16 + (size_t)NREAL * 1024 + off) = pack4_bf16(o); float ss = (o[0] * o[0] + o[1] * o[1]) + (o[2] * o[2] + o[3] * o[3]); ss += __shfl_xor(ss, 16); ss += __shfl_xor(ss, 32);
                  if (fq_ == 0) ((float*)(ws + WS_SSPM))[fr_ * 64 + t] = ss; } }
            constexpr int MR = TAIL_ON(1) ? NREAL : RPAD; pg8::Gemm g{(const bf16_t*)(ws + F_O), (const bf16_t*)(ws + WA_FOUT), MR, 1024, 1024}; pg8::StaticOrder S; S.init(MR, 1024, C.G, (int)blockIdx.x);
            pg8::EpiResidT<true> E{H16, H16, (float*)(ws + WS_SSP), 1.0f, 0};
            pg8::gemm_phase<pg8::EpiResidT<true>, pg8::StaticOrder, true, true>(C.lds, g, S, E);
        }
        SEAMP(4);
        if (INP(6)) { PHASE_LOCALS
            static_assert(!CFG_F8_FFN0 && !CFG_F8_FFN2, "the meta-row tail of the dense FFN is bf16 only");
            if (TAIL_ON(2)) for (int t = tw; t < 176; t += C.NGW) { const int pn = t >> 3, s = t & 7; const bf16_t* A16 = H16 + (size_t)NREAL * 1024; const bf16_t* Bt = (const bf16_t*)(ws + WA_FFIN) + (size_t)(pn * 256 + 16 * s) * 1024;
                f32x4 g4 = tail_tile(A16, 1024, Bt, 1024, 1024, C.lane), u4 = tail_tile(A16, 1024, Bt + (size_t)128 * 1024, 1024, 1024, C.lane); f32x4 o;
                { const float* sp = (const float*)(ws + WS_SSPM) + fr_ * 64; float s = 0.f;
#pragma unroll
                  for (int q = 0; q < 16; ++q) { const f32x4 x = *(const f32x4*)(sp + 4 * q); s += (x[0] + x[1]) + (x[2] + x[3]); }
                  const float rs = 1.0f / sqrtf(s * (1.0f / 1024.0f) + EPSN); g4 = g4 * rs; u4 = u4 * rs; }
#pragma unroll
                for (int j = 0; j < 4; ++j) o[j] = g4[j] * fast_sigmoid(g4[j]) * u4[j];
                *(u32x2*)((bf16_t*)(ws + D_HF) + (size_t)(NREAL + fr_) * DFF + pn * 128 + 16 * s + 4 * fq_) = pack4_bf16(o); }
            constexpr int MR = TAIL_ON(2) ? NREAL : RPAD; pg8::StaticOrder S; S.init(MR, 5632, C.G, (int)blockIdx.x);
            if (f8ffn) { pg8::Gemm g{XN, (const bf16_t*)(ws + WA_FFIN), NREAL, 5632, 512}; pg8::EpiSwiglu<true> E{ws + D_HF, nullptr, 1.0f / (F8_SX * F8_SW), 0};
                pg8::gemm_phase<pg8::EpiSwiglu<true>, pg8::StaticOrder, true, true, true>(C.lds, g, S, E); }
            else { pg8::Gemm g{H16, (const bf16_t*)(ws + WA_FFIN), NREAL, 5632, 1024}; pg8::EpiSwiglu<false> E{ws + D_HF, (const float*)(ws + WS_SSP), 1.0f, 0};
                pg8::gemm_phase<pg8::EpiSwiglu<false>, pg8::StaticOrder, true, true, false>(C.lds, g, S, E); }
        }
        SEAMP(6);
        if (INP(7)) { PHASE_LOCALS
            if (TAIL_ON(3)) for (int t = tw; t < 64; t += C.NGW) { const f32x4 a = tail_tile((const bf16_t*)(ws + D_HF) + (size_t)NREAL * DFF, DFF, (const bf16_t*)(ws + WA_FFOUT) + (size_t)16 * t * DFF, DFF, DFF, C.lane);
                const size_t off = (size_t)fr_ * 1024 + 16 * t + 4 * fq_; const f32x4 o = *(const f32x4*)(hmeta + off) + a; *(f32x4*)(hmeta + off) = o; *(u32x2*)(H16 + (size_t)NREAL * 1024 + off) = pack4_bf16(o); }
            constexpr int MR = TAIL_ON(3) ? NREAL : RPAD; pg8::StaticOrder S; S.init(MR, 1024, C.G, (int)blockIdx.x);
            if (f8ffn) { pg8::Gemm g{(const bf16_t*)(ws + D_HF), (const bf16_t*)(ws + WA_FFOUT), NREAL, 1024, DFF / 2}; pg8::EpiResidT<false> E{H16, H16, nullptr, 1.0f / (F8_SH * F8_SW), 0};
                pg8::gemm_phase<pg8::EpiResidT<false>, pg8::StaticOrder, true, true, true>(C.lds, g, S, E); }
            else { pg8::Gemm g{(const bf16_t*)(ws + D_HF), (const bf16_t*)(ws + WA_FFOUT), NREAL, 1024, DFF}; pg8::EpiResidT<false> E{H16, H16, nullptr, 1.0f, 0};
                pg8::gemm_phase<pg8::EpiResidT<false>, pg8::StaticOrder, true, true, false>(C.lds, g, S, E); }
        }
        SEAMP(7);
        if (INP(9)) { PHASE_LOCALS
            for (int b = 0; b < NB; ++b) { zero_bytes(ws + M_VP + (size_t)(b * LP + LVALID) * 2048, (size_t)(LP - LVALID) * 2048, C); zero_bytes(ws + M_KP + (size_t)(b * LP + LVALID) * 3072, (size_t)(LP - LVALID) * 3072, C); }
            if (TAIL_ON(4)) for (int t = tw; t < 32; t += C.NGW) *(u32x2*)((bf16_t*)(ws + M_CRAW) + (size_t)(NREAL + fr_) * 512 + 16 * t + 4 * fq_) = pack4_bf16(tail_tile(H16 + (size_t)NREAL * 1024, 1024, (const bf16_t*)(ws + WB_MIN) + (size_t)16 * t * 1024, 1024, 1024, C.lane));
            constexpr int MR = TAIL_ON(4) ? NREAL : RPAD; pg8::Gemm g{H16, (const bf16_t*)(ws + WB_MIN), MR, 512, 1024}; pg8::StaticOrder S; S.init(MR, 512, C.G, (int)blockIdx.x);
            pg8::EpiStore E{(bf16_t*)(ws + M_CRAW), 512, 1.0f};
            pg8::gemm_phase<pg8::EpiStore, pg8::StaticOrder, true, true>(C.lds, g, S, E);
        }
        SEAMP(9);
        if (INP(10)) { PHASE_LOCALS
            const bf16_t* CR = (const bf16_t*)(ws + M_CRAW); bf16_t* CQ = (bf16_t*)(ws + M_CQ); bf16_t* CKV = (bf16_t*)(ws + M_CKV); bf16_t* KPb = (bf16_t*)(ws + M_KP);
            const int l = C.lane; const float* gp = l < 32 ? WP(11) + 8 * l : (l < 48 ? WP(13) + 8 * (l - 32) : WP(17) + 8 * ((l - 48) & 3));
            const f32x4 g0 = *(const f32x4*)gp, g1 = *(const f32x4*)(gp + 4);
#define P10_LOAD(mm) do { raw_n = *(const u32x4*)(CR + (size_t)(mm) * 512 + 8 * l); const int lr_ = (mm) < NREAL ? row_to_lrow(mm) : (mm) - NREAL; const float* rp_ = rope + (size_t)lr_ * 32 + 8 * (l & 1); \
                rc0_n = *(const f32x4*)rp_; rc1_n = *(const f32x4*)(rp_ + 4); rq0_n = *(const f32x4*)(rp_ + 16); rq1_n = *(const f32x4*)(rp_ + 20); } while (0)
            u32x4 raw_n = {0u, 0u, 0u, 0u}; f32x4 rc0_n = {0.f, 0.f, 0.f, 0.f}, rc1_n = rc0_n, rq0_n = rc0_n, rq1_n = rc0_n; if (C.gw < NROWS) P10_LOAD(C.gw);
            for (int m = C.gw; m < NROWS; m += C.NGW) {
                const u32x4 raw = raw_n; const f32x4 c0 = rc0_n, c1 = rc1_n, q0 = rq0_n, q1 = rq1_n; if (m + C.NGW < NROWS) P10_LOAD(m + C.NGW);
                float xv[8];
#pragma unroll
                for (int j = 0; j < 4; ++j) { xv[2 * j] = bf_lo(raw[j]); xv[2 * j + 1] = bf_hi(raw[j]); }
                float s0 = 0.f;
#pragma unroll
                for (int j = 0; j < 8; ++j) s0 += xv[j] * xv[j];
                const float s1 = s0 + __shfl_xor(s0, 1), s2 = s1 + __shfl_xor(s1, 2), s3 = s2 + __shfl_xor(s2, 4), s4 = s3 + __shfl_xor(s3, 8), s5 = s4 + __shfl_xor(s4, 16);
                const float rn = __builtin_amdgcn_rsqf(l < 32 ? s5 * (1.0f / 256.0f) + EPSN : (l < 48 ? s4 * (1.0f / 128.0f) + EPSN : s2 * (1.0f / 32.0f) + EPSN));
#pragma unroll
                for (int j = 0; j < 4; ++j) { xv[j] *= rn * g0[j]; xv[4 + j] *= rn * g1[j]; }
                float pt[8];
#pragma unroll
                for (int j = 0; j < 8; ++j) pt[j] = __shfl_xor(xv[j], 2);
                if (l >= 48 && l < 52) {
                    const float sgn = (l < 50) ? -1.0f : 1.0f;
#pragma unroll
                    for (int j = 0; j < 8; ++j) { const float c = j < 4 ? c0[j & 3] : c1[j & 3], s = j < 4 ? q0[j & 3] : q1[j & 3]; xv[j] = xv[j] * c + sgn * pt[j] * s; }
                }
                u32x4 o;
#pragma unroll
                for (int j = 0; j < 4; ++j) o[j] = cvt_pk_bf16(xv[2 * j], xv[2 * j + 1]);
                { bf16_t* dst = l < 32 ? CQ + (size_t)m * 256 + 8 * l : CKV + (size_t)m * 256 + 8 * (l - 32); const u32x4 ov = l < 48 ? o : (u32x4){0u, 0u, 0u, 0u}; *(u32x4*)dst = ov; }
                {
                    u32x4 ob;
#pragma unroll
                    for (int j = 0; j < 4; ++j) ob[j] = (unsigned)__shfl((int)o[j], 48 + (l & 3));
                    const bool meta = m >= NREAL; const int lrow0 = meta ? m - NREAL : row_to_lrow(m);
                    bf16_t* kd = KPb + (size_t)lrow0 * 1536 + (l >> 2) * 96 + 64 + 8 * (l & 3); *(u32x4*)kd = ob;
                    if (meta) for (int d = 1; d < NB; ++d) *(u32x4*)(kd + (size_t)d * LP * 1536) = ob; }
            }
#undef P10_LOAD
        }
        SEAMP(10);
        if (INP(11)) { PHASE_LOCALS
            constexpr int MR = TAIL_ON(5) ? NREAL : RPAD;
            if (TAIL_ON(5)) for (int t = tw; t < 96 + 128; t += C.NGW) {
                if (t < 96) *(u32x2*)((bf16_t*)(ws + M_QRAW) + (size_t)(NREAL + fr_) * 1536 + 16 * t + 4 * fq_) = pack4_bf16(tail_tile((const bf16_t*)(ws + M_CQ) + (size_t)NREAL * 256, 256, (const bf16_t*)(ws + WB_QUP) + (size_t)16 * t * 256, 256, 256, C.lane));
                else if (t < 96 + 64) { if (t < 96 + 16) { const int hh = t - 96; tail_khead<96>((const bf16_t*)(ws + M_CKV) + (size_t)NREAL * 256, 256, (const bf16_t*)(ws + WB_KVUP) + (size_t)((hh >> 2) * 256 + (hh & 3) * 32) * 256, 256, WP(16), (bf16_t*)(ws + M_KP), hh, C.lane); } }
                else { const int t2 = t - 96; const u32x2 w = pack4_bf16(tail_tile((const bf16_t*)(ws + M_CKV) + (size_t)NREAL * 256, 256, (const bf16_t*)(ws + WB_KVUP) + (size_t)16 * t2 * 256, 256, 256, C.lane)); const int col = 16 * t2 + 4 * fq_;
                    for (int b = 0; b < NB; ++b) *(u32x2*)((bf16_t*)(ws + M_VP) + (size_t)(b * LP + fr_) * 1024 + col - 1024) = w; } }
            { pg8::Gemm g{(const bf16_t*)(ws + M_CQ), (const bf16_t*)(ws + WB_QUP), MR, 1536, 256}; pg8::StaticOrder S; S.init(MR, 1536, C.G, (int)blockIdx.x);
              pg8::EpiStore E{(bf16_t*)(ws + M_QRAW), 1536, 1.0f};
              pg8::gemm_phase<pg8::EpiStore, pg8::StaticOrder, true, true>(C.lds, g, S, E); }
            __syncthreads(); asm volatile("" ::: "memory");
            { pg8::Gemm g{(const bf16_t*)(ws + M_CKV), (const bf16_t*)(ws + WB_KVUP), MR, 2048, 256}; pg8::StaticOrder S; S.init(MR, 2048, C.G, (int)blockIdx.x);
              pg8::EpiKvUp E{(bf16_t*)(ws + M_KP), WP(16), (bf16_t*)(ws + M_VP)};
              pg8::gemm_phase<pg8::EpiKvUp, pg8::StaticOrder, true, true>(C.lds, g, S, E); }
        }
        SEAMP(11);
        if (INP(13)) { PHASE_LOCALS
            const attn_body::AttnArgs AT{(const bf16_t*)(ws + M_QRAW), (const bf16_t*)(ws + M_KP), (const bf16_t*)(ws + M_VP), (bf16_t*)(ws + M_O), nullptr, WP(15), nullptr, rope};
            if (attn_body::attn_fixref_ok<1>(WP(15), WP(16), WP(17), C.lane)) attn_body::attn_phase<6, 1, 8, true>((char*)lds_raw, AT, (unsigned*)(ctl + CW_ATTQ + (2 * lp + 1) * 64));
            else attn_body::attn_phase<6, 1, 8, false>((char*)lds_raw, AT, (unsigned*)(ctl + CW_ATTQ + (2 * lp + 1) * 64));
        }
        SEAMP(13);
        if (INP(14)) { PHASE_LOCALS
            if (TAIL_ON(6)) for (int t = tw; t < 64; t += C.NGW) { const f32x4 a = tail_tile((const bf16_t*)(ws + M_O) + (size_t)NREAL * 1024, 1024, (const bf16_t*)(ws + WB_MOUT) + (size_t)16 * t * 1024, 1024, 1024, C.lane);
                const size_t off = (size_t)fr_ * 1024 + 16 * t + 4 * fq_; *(f32x4*)(hmeta + off) = *(const f32x4*)(hmeta + off) + a; }
            constexpr int MR = TAIL_ON(6) ? NREAL : RPAD; pg8::Gemm g{(const bf16_t*)(ws + M_O), (const bf16_t*)(ws + WB_MOUT), MR, 1024, 1024}; pg8::StaticOrder S; S.init(MR, 1024, C.G, (int)blockIdx.x);
            pg8::EpiResidT<false> E{H16, H16, nullptr, 1.0f, 0};
            pg8::gemm_phase<pg8::EpiResidT<false>, pg8::StaticOrder, true, true>(C.lds, g, S, E);
        }
        SEAMP(14);
        if (INP(15)) { PHASE_LOCALS
            constexpr int RB = 129;
            LAS int* lcnt = (LAS int*)C.lds; LAS int* lbase = lcnt + 8; LAS unsigned* lrec = (LAS unsigned*)(lbase + 8);
            if (C.tid < 8) lcnt[C.tid] = 0;
            __syncthreads();
            f32x4 gv[4]; load_gain(WP(19), gv, C.lane);
            float wr[16][8];
#pragma unroll
            for (int j = 0; j < 4; ++j)
#pragma unroll
                for (int i = 0; i < 4; ++i) { const float* p = WP(20) + (size_t)(4 * C.lane + 256 * j + i) * 8; const f32x4 a = *(const f32x4*)p, b = *(const f32x4*)(p + 4);
#pragma unroll
                    for (int e = 0; e < 4; ++e) { wr[4 * j + i][e] = a[e]; wr[4 * j + i][4 + e] = b[e]; } }
            const int rb = (C.G == 256 ? C.vcu : (int)blockIdx.x) * RB; const int nrows = rb >= NROWS ? 0 : (NROWS - rb < RB ? NROWS - rb : RB);
            f32x4 v[4] = {}; if (C.wave < nrows) LOAD_H(rb + C.wave, v);
            for (int ri = C.wave; ri < nrows; ri += NWAVES) { const int m = rb + ri; f32x4 nv[4] = {v[0], v[1], v[2], v[3]}; if (ri + NWAVES < nrows) LOAD_H(m + NWAVES, nv);
                if (f8moe) norm_row<true>(v, gv, (unsigned char*)XN + (size_t)m * 1024, C.lane); else norm_row(v, gv, XN + (size_t)m * 1024, C.lane);
                float lg[8];
#pragma unroll
                for (int e = 0; e < 8; ++e) { float s = 0.f;
#pragma unroll
                    for (int j = 0; j < 4; ++j) s += (v[j].x * wr[4 * j][e] + v[j].y * wr[4 * j + 1][e]) + (v[j].z * wr[4 * j + 2][e] + v[j].w * wr[4 * j + 3][e]);
                    lg[e] = wave_sum(s); }
                int e0 = 0; float l0 = lg[0];
#pragma unroll
                for (int e = 1; e < 8; ++e) if (lg[e] > l0) { l0 = lg[e]; e0 = e; }
                int e1 = -1; float l1 = -INFINITY;
#pragma unroll
                for (int e = 0; e < 8; ++e) if (e != e0 && lg[e] > l1) { l1 = lg[e]; e1 = e; }
                if (e1 < 0) e1 = (e0 + 1) & 7;
                const float w1 = 1.0f / (1.0f + expf(l0 - l1)), w0 = 1.0f - w1;
                if (C.lane == 0) { const int p0 = __hip_atomic_fetch_add(lcnt + e0, 1, __ATOMIC_RELAXED, __HIP_MEMORY_SCOPE_WORKGROUP), p1 = __hip_atomic_fetch_add(lcnt + e1, 1, __ATOMIC_RELAXED, __HIP_MEMORY_SCOPE_WORKGROUP);
                    LAS unsigned* r = lrec + ri * 6; r[0] = (unsigned)e0; r[1] = (unsigned)e1; r[2] = (unsigned)p0; r[3] = (unsigned)p1; r[4] = __float_as_uint(w0); r[5] = __float_as_uint(w1); }
#pragma unroll
                for (int j = 0; j < 4; ++j) v[j] = nv[j];
            }
            __syncthreads();
            if (C.tid < 8) lbase[C.tid] = (int)__hip_atomic_fetch_add(cnt + 64 * C.tid, (unsigned)lcnt[C.tid], RLX_AGENT);
            __syncthreads();
            for (int ri = C.tid; ri < nrows; ri += NTHREADS) { const LAS unsigned* r = lrec + ri * 6; unsigned* o = route + (size_t)(rb + ri) * 8;
                *(u32x4*)o = (u32x4){r[0], r[1], r[2] + (unsigned)lbase[r[0]], r[3] + (unsigned)lbase[r[1]]}; *(u32x2*)(o + 4) = (u32x2){r[4], r[5]}; }
        }
        SEAMP(15);
        if (INP(16)) { PHASE_LOCALS
            int roff[9]; moe_offsets(cnt, roff);
            bf16_t* XG = (bf16_t*)(ws + E_XG);
            const int rowb = f8moe ? 1024 : 2048;
            u32x4 ra_n = {0u, 0u, 0u, 0u}, a_n = ra_n, b_n = ra_n;
            if (C.gw < NROWS) { ra_n = *(const u32x4*)(route + (size_t)C.gw * 8); a_n = *(const u32x4*)((const unsigned char*)XN + (size_t)C.gw * rowb + 16 * C.lane); if (!f8moe) b_n = *(const u32x4*)((const unsigned char*)XN + (size_t)C.gw * rowb + 1024 + 16 * C.lane); }
            for (int m = C.gw; m < NROWS; m += C.NGW) { const u32x4 ra = ra_n, a = a_n, b = b_n; const int mn = m + C.NGW;
                if (mn < NROWS) { ra_n = *(const u32x4*)(route + (size_t)mn * 8); a_n = *(const u32x4*)((const unsigned char*)XN + (size_t)mn * rowb + 16 * C.lane); if (!f8moe) b_n = *(const u32x4*)((const unsigned char*)XN + (size_t)mn * rowb + 1024 + 16 * C.lane); }
                const int e0 = (int)ra.x, e1 = (int)ra.y; int d0 = 0, d1 = 0;
#pragma unroll
                for (int e = 0; e < 8; ++e) { d0 = e0 == e ? roff[e] : d0; d1 = e1 == e ? roff[e] : d1; }
                d0 = d0 * 256 + (int)ra.z; d1 = d1 * 256 + (int)ra.w;
                if (f8moe) { *(u32x4*)((unsigned char*)XG + (size_t)d0 * 1024 + 16 * C.lane) = a; *(u32x4*)((unsigned char*)XG + (size_t)d1 * 1024 + 16 * C.lane) = a; }
                else { *(u32x4*)((unsigned char*)XG + (size_t)d0 * 2048 + 16 * C.lane) = a; *(u32x4*)((unsigned char*)XG + (size_t)d0 * 2048 + 1024 + 16 * C.lane) = b;
                    *(u32x4*)((unsigned char*)XG + (size_t)d1 * 2048 + 16 * C.lane) = a; *(u32x4*)((unsigned char*)XG + (size_t)d1 * 2048 + 1024 + 16 * C.lane) = b; } }
        }
        SEAMP(16);
        if (INP(17)) { PHASE_LOCALS
            if (f8moe) { pg8::MoeOrder S; const int ntm = moe_offsets(cnt, S.toff); S.nM = ntm; S.nN = 22; S.nwg = ntm * 22; S.G = C.G; S.c = (int)blockIdx.x;
                pg8::Gemm g{(const bf16_t*)(ws + E_XG), (const bf16_t*)(ws + WB_MOEIN), ntm * 256, 5632, 512}; pg8::EpiSwiglu<true> E{ws + E_HF, nullptr, 1.0f / (F8_SX * F8_SW), 0};
                pg8::gemm_phase<pg8::EpiSwiglu<true>, pg8::MoeOrder, true, true, true>(C.lds, g, S, E); }
            else { pg8::MoeOrder S; const int ntm = moe_offsets(cnt, S.toff); S.nM = ntm; S.nN = 22; S.nwg = ntm * 22; S.G = C.G; S.c = (int)blockIdx.x;
                pg8::Gemm g{(const bf16_t*)(ws + E_XG), (const bf16_t*)(ws + WB_MOEIN), ntm * 256, 5632, 1024}; pg8::EpiSwiglu<false> E{ws + E_HF, nullptr, 1.0f, 0};
                pg8::gemm_phase<pg8::EpiSwiglu<false>, pg8::MoeOrder, true, true, false>(C.lds, g, S, E); }
        }
        SEAMP(17);
        if (INP(18)) { PHASE_LOCALS
            if (f8moe) { pg8::MoeOrder S; const int ntm = moe_offsets(cnt, S.toff); S.nM = ntm; S.nN = 4; S.nwg = ntm * 4; S.G = C.G; S.c = (int)blockIdx.x;
                pg8::Gemm g{(const bf16_t*)(ws + E_HF), (const bf16_t*)(ws + WB_MOEOUT), ntm * 256, 1024, DFF / 2}; pg8::EpiStore E{(bf16_t*)(ws + E_Y), 1024, 1.0f / (F8_SH * F8_SW)};
                pg8::gemm_phase<pg8::EpiStore, pg8::MoeOrder, true, true, true>(C.lds, g, S, E); }
            else { pg8::MoeOrder S; const int ntm = moe_offsets(cnt, S.toff); S.nM = ntm; S.nN = 4; S.nwg = ntm * 4; S.G = C.G; S.c = (int)blockIdx.x;
                pg8::Gemm g{(const bf16_t*)(ws + E_HF), (const bf16_t*)(ws + WB_MOEOUT), ntm * 256, 1024, DFF}; pg8::EpiStore E{(bf16_t*)(ws + E_Y), 1024, 1.0f};
                pg8::gemm_phase<pg8::EpiStore, pg8::MoeOrder, true, true, false>(C.lds, g, S, E); }
        }
        SEAMP(18);
    }
    if (PHEN(19) && IN(2 * NPH)) { const int lp = 1; PHASE_LOCALS
        int roff[9]; moe_offsets(cnt, roff);
#pragma unroll
        for (int e = 0; e < 9; ++e) roff[e] *= 256;
        { f32x4 v[4] = {}; u32x4 ra = {0u, 0u, 0u, 0u}; u32x2 rb = {0u, 0u}; int m = C.gw;
          if (m < NREAL) { load_row16(H16 + (size_t)m * 1024, v, C.lane); ra = *(const u32x4*)(route + (size_t)m * 8); rb = *(const u32x2*)(route + (size_t)m * 8 + 4); }
          for (; m < NREAL; m += C.NGW) { const int mn = m + C.NGW; f32x4 nv[4] = {v[0], v[1], v[2], v[3]}; u32x4 nra = {0u, 0u, 0u, 0u}; u32x2 nrb = {0u, 0u};
              if (mn < NREAL) { load_row16(H16 + (size_t)mn * 1024, nv, C.lane); nra = *(const u32x4*)(route + (size_t)mn * 8); nrb = *(const u32x2*)(route + (size_t)mn * 8 + 4); }
              moe_combine_row(v, ra, rb, roff, (const bf16_t*)(ws + E_Y), C.lane); store_row(hreal + (size_t)m * 1024, v, C.lane);
#pragma unroll
              for (int j = 0; j < 4; ++j) v[j] = nv[j];
              ra = nra; rb = nrb; } }
    }
#undef IN
#undef SEAM
#undef LOAD_H
#undef STORE_H
#undef WP
}

#ifndef MK_LAUNCH_PER_PHASE
#define MK_LAUNCH_PER_PHASE 0
#endif
extern "C" void kernel_launch(void* const* d_in, const int* in_sizes, int n_in, void* d_out, int out_size, void* d_ws, size_t ws_size, hipStream_t stream) {
    static int grid = 0;
    if (grid == 0) {
        if (n_in != 49 || in_sizes[0] != NREAL * 1024 || out_size != NREAL * 1024 || ws_size < WS_NEED) { fprintf(stderr, "kernel_launch: unexpected problem (n_in %d, in0 %d, out %d, ws %zu < %zu); nothing launched\n", n_in, n_in > 0 ? in_sizes[0] : -1, out_size, ws_size, (size_t)WS_NEED); grid = -1; return; }
        int dev = 0, cus = 0, per_cu = 0;
        if (hipGetDevice(&dev) != hipSuccess || hipDeviceGetAttribute(&cus, hipDeviceAttributeMultiprocessorCount, dev) != hipSuccess) { grid = -1; return; }
        if (hipFuncSetAttribute((const void*)trunk_fwd, hipFuncAttributeMaxDynamicSharedMemorySize, LDS_BYTES) != hipSuccess) { fprintf(stderr, "kernel_launch: hipFuncSetAttribute failed\n"); grid = -1; return; }
        if (hipOccupancyMaxActiveBlocksPerMultiprocessor(&per_cu, (const void*)trunk_fwd, NTHREADS, LDS_BYTES) != hipSuccess || per_cu < 1) { fprintf(stderr, "kernel_launch: occupancy query says %d blocks per CU\n", per_cu); }
        (void)hipGetLastError();
        grid = cus;
    }
    if (grid < 0) return;
    (void)hipMemsetAsync((char*)d_ws + WS_CTL, 0, CTL_ZERO_BYTES, stream);
    Args a{};
    for (int i = 0; i < 49; ++i) a.in[i] = (const float*)d_in[i];
    a.out = (float*)d_out; a.ws = (unsigned char*)d_ws;
#if MK_LAUNCH_PER_PHASE
    for (int p = 0; p < N_PHASES; ++p) { a.ph_lo = p; a.ph_hi = p + 1; hipLaunchKernelGGL(trunk_fwd, dim3(grid), dim3(NTHREADS), LDS_BYTES, stream, a); }
#else
    a.ph_lo = 0; a.ph_hi = N_PHASES;
    hipLaunchKernelGGL(trunk_fwd, dim3(grid), dim3(NTHREADS), LDS_BYTES, stream, a);
#endif
}
```

```cpp
#include <hip/hip_runtime.h>
#include <hip/hip_bf16.h>
#include <cstdio>
#include <cstdint>
#include <cmath>
#include <type_traits>

constexpr int NB = 4, SEQ = 8192, DM_ = 1024, NMETA = 16, LP = 8448, NREAL = NB * SEQ, NROWS = NREAL + NMETA, RPAD = NREAL + 256, LROWS = NB * LP;
constexpr int LVALID = SEQ + NMETA;
constexpr int DFF = 2816, NEXP = 8, NHEADS = 16;
constexpr int RG_MAX = 67840;
constexpr float EPSN = 1e-6f, LOG2E = 1.4426950408889634f;

#define GAS __attribute__((address_space(1)))
#define LAS __attribute__((address_space(3)))
typedef unsigned short bf16_t;
typedef short bf16x8 __attribute__((ext_vector_type(8)));
typedef float f32x4 __attribute__((ext_vector_type(4)));
typedef float f32x2 __attribute__((ext_vector_type(2)));
typedef unsigned u32x4 __attribute__((ext_vector_type(4)));
typedef unsigned u32x2 __attribute__((ext_vector_type(2)));

typedef __bf16 bf16x2_cv __attribute__((ext_vector_type(2)));
__device__ __forceinline__ unsigned cvt_pk_bf16(float lo, float hi) { const f32x2 v = {lo, hi}; return __builtin_bit_cast(unsigned, __builtin_convertvector(v, bf16x2_cv)); }
__device__ __forceinline__ float bf_lo(unsigned w) { return __uint_as_float(w << 16); }
__device__ __forceinline__ float bf_hi(unsigned w) { return __uint_as_float(w & 0xffff0000u); }
__device__ __forceinline__ float bf2f(bf16_t x) { return __uint_as_float((unsigned)x << 16); }
__device__ __forceinline__ bf16_t f2bf(float f) { return (bf16_t)(cvt_pk_bf16(f, 0.f) & 0xffffu); }
__device__ __forceinline__ unsigned pack4_fp8(float a, float b, float c, float d) {
    a = __builtin_amdgcn_fmed3f(a, -448.f, 448.f); b = __builtin_amdgcn_fmed3f(b, -448.f, 448.f); c = __builtin_amdgcn_fmed3f(c, -448.f, 448.f); d = __builtin_amdgcn_fmed3f(d, -448.f, 448.f);
    int p = __builtin_amdgcn_cvt_pk_fp8_f32(a, b, 0, false); p = __builtin_amdgcn_cvt_pk_fp8_f32(c, d, p, true); return (unsigned)p;
}
constexpr float F8_SX = 16.0f, F8_SH = 8.0f, F8_SW = 128.0f;
__device__ __forceinline__ float fast_sigmoid(float x) { return __builtin_amdgcn_rcpf(1.0f + __builtin_amdgcn_exp2f(-x * LOG2E)); }
__device__ __forceinline__ float wave_sum(float v) {
#pragma unroll
    for (int o = 1; o < 64; o <<= 1) v += __shfl_xor(v, o);
    return v;
}
__device__ __forceinline__ int lpos_to_row(int b, int pos) { return pos < NMETA ? NREAL + pos : b * SEQ + pos - NMETA; }
__device__ __forceinline__ int row_to_lrow(int r) { return r + NMETA + (r >> 13) * (LP - SEQ); }

namespace pg8 {
#define PG8_LAS __attribute__((address_space(3)))
constexpr int BM = 256, BK = 64, HALF = 128, HTB = HALF * BK * 2  , STAGE_BYTES = 8 * HTB, NXCD = 8, WGM = 8;

__host__ __device__ __forceinline__ int lds_byte(int r, int c) { const int st = (r >> 4) * 2 + (c >> 5), rr = r & 15, cc = c & 31, ob = rr * 64 + cc * 2; return st * 1024 + (ob ^ (((ob >> 9) & 1) << 5)); }
__host__ __device__ __forceinline__ void stage_rc(int b, int& R, int& C) { const int st = b / 1024, sb = b % 1024, swz = sb ^ (((sb >> 9) & 1) << 5); R = (st >> 1) * 16 + swz / 64; C = (st & 1) * 32 + (swz % 64) / 2; }
__host__ __device__ __forceinline__ int perm32(int rho) { const int n = rho >> 4, i = rho & 15; return 8 * (i >> 2) + 4 * n + (i & 3); }

struct Unit { int pm, pn, pb; };
struct Gemm { const bf16_t* A; const bf16_t* Bt; int M, N, K; };

__host__ __device__ __forceinline__ int xcd_remap(int wgid, int nwg) { const int q = nwg / NXCD, r = nwg % NXCD, xcd = wgid % NXCD, off = wgid / NXCD; return (xcd < r ? xcd * (q + 1) : r * (q + 1) + (xcd - r) * q) + off; }
struct StaticOrder {
    int nM, nN, nwg, G, c;
    __host__ __device__ void init(int M, int N, int G_, int c_) { nM = M / BM; nN = N / BM; nwg = nM * nN; G = G_; c = c_; }
    __host__ __device__ bool next(int i, Unit& u) const {
        const long L = (long)i * G + c; if (L >= nwg) return false;
        const int wgid = xcd_remap((int)L, nwg);
        const int nig = WGM * nN, gid = wgid / nig, fm = gid * WGM, gsz = (nM - fm) < WGM ? (nM - fm) : WGM;
        u.pm = fm + ((wgid % nig) % gsz); u.pn = (wgid % nig) / gsz; u.pb = u.pn; return true;
    }
    __device__ __forceinline__ void a_ready(const Unit&) const {}
    __device__ __forceinline__ void done(const Unit&) const {}
};
struct MoeOrder {
    int nM, nN, nwg, G, c; int toff[9];
    __device__ bool next(int i, Unit& u) const {
        const long L = (long)i * G + c; if (L >= nwg) return false;
        const int wgid = xcd_remap((int)L, nwg);
        const int nig = WGM * nN, gid = wgid / nig, fm = gid * WGM, gsz = (nM - fm) < WGM ? (nM - fm) : WGM;
        const int pm = fm + ((wgid % nig) % gsz), pn = (wgid % nig) / gsz;
        int e = 0;
#pragma unroll
        for (int k = 1; k < 8; ++k) e += (pm >= toff[k]) ? 1 : 0;
        u.pm = pm; u.pn = pn; u.pb = e * nN + pn; return true;
    }
    __device__ __forceinline__ void a_ready(const Unit&) const {}
    __device__ __forceinline__ void done(const Unit&) const {}
};

typedef f32x4 Acc[2][2][4][2];

__device__ __forceinline__ u32x4 pack8(const f32x4 v0, const f32x4 v1) { u32x4 w; w.x = cvt_pk_bf16(v0[0], v0[1]); w.y = cvt_pk_bf16(v0[2], v0[3]); w.z = cvt_pk_bf16(v1[0], v1[1]); w.w = cvt_pk_bf16(v1[2], v1[3]); return w; }

__device__ __forceinline__ void store_tile_bf16(const Acc& acc, bf16_t* O, int ld, int row_base, int col_base, int wr, int wc, int fr, int fq) {
    const int row0 = row_base + wr * 64 + fr, col0 = col_base + wc * 32 + 8 * fq;
#pragma unroll
    for (int ai = 0; ai < 2; ++ai)
#pragma unroll
        for (int m = 0; m < 4; ++m) { bf16_t* rowp = O + (size_t)(row0 + ai * HALF + m * 16) * ld + col0;
#pragma unroll
            for (int bj = 0; bj < 2; ++bj) *(u32x4*)(rowp + bj * HALF) = pack8(acc[ai][bj][m][0], acc[ai][bj][m][1]); }
}
__device__ __forceinline__ void store_tile_lspace(const Acc& acc, bf16_t* O, int pm, int col_base, int wr, int wc, int fr, int fq) {
    const int col0 = col_base + wc * 32 + 8 * fq;
    if (pm < NREAL / BM) {
        const int row0 = pm * BM + NMETA + (pm >> 5) * (LP - SEQ) + wr * 64 + fr;
#pragma unroll
        for (int ai = 0; ai < 2; ++ai)
#pragma unroll
            for (int m = 0; m < 4; ++m) { bf16_t* rowp = O + (size_t)(row0 + ai * HALF + m * 16) * 1024 + col0;
#pragma unroll
                for (int bj = 0; bj < 2; ++bj) *(u32x4*)(rowp + bj * HALF) = pack8(acc[ai][bj][m][0], acc[ai][bj][m][1]); }
    } else if (wr == 0) {
#pragma unroll
        for (int b = 0; b < NB; ++b) { bf16_t* rowp = O + (size_t)(b * LP + fr) * 1024 + col0;
#pragma unroll
            for (int bj = 0; bj < 2; ++bj) *(u32x4*)(rowp + bj * HALF) = pack8(acc[0][bj][0][0], acc[0][bj][0][1]); }
    }
}

struct EpiStore {
    static constexpr bool PERM = true, AFTER_DRAIN = false;
    bf16_t* O; int ld; float sc;
    __device__ __forceinline__ void operator()(const Acc& acc, const Unit& u, int wr, int wc, int fr, int fq) const {
        const int row0 = u.pm * BM + wr * 64 + fr, col0 = u.pn * BM + wc * 32 + 8 * fq;
#pragma unroll
        for (int ai = 0; ai < 2; ++ai)
#pragma unroll
            for (int m = 0; m < 4; ++m) { bf16_t* rowp = O + (size_t)(row0 + ai * HALF + m * 16) * ld + col0;
#pragma unroll
                for (int bj = 0; bj < 2; ++bj) *(u32x4*)(rowp + bj * HALF) = pack8(acc[ai][bj][m][0] * sc, acc[ai][bj][m][1] * sc); }
    }
};
template <int DKP> __device__ __forceinline__ void store_tile_knorm(const Acc& acc, bf16_t* Kp, const float* gk, int pm, int ht, int wr, int wc, int fr, int fq) {
    const int head = 4 * ht + wc; const int row0 = pm * BM + NMETA + (pm >> 5) * (LP - SEQ) + wr * 64 + fr;
    f32x4 g[2][2];
#pragma unroll
    for (int bj = 0; bj < 2; ++bj)
#pragma unroll
        for (int n = 0; n < 2; ++n) g[bj][n] = *(const f32x4*)(gk + 32 * bj + 8 * fq + 4 * n);
#pragma unroll
    for (int ai = 0; ai < 2; ++ai)
#pragma unroll
        for (int m = 0; m < 4; ++m) { float ss = 0.f;
#pragma unroll
            for (int bj = 0; bj < 2; ++bj)
#pragma unroll
                for (int n = 0; n < 2; ++n) { const f32x4 x = acc[ai][bj][m][n]; ss += (x[0] * x[0] + x[1] * x[1]) + (x[2] * x[2] + x[3] * x[3]); }
            ss += __shfl_xor(ss, 16); ss += __shfl_xor(ss, 32);
            const float rn = __builtin_amdgcn_rsqf(ss * (1.0f / 64.0f) + EPSN);
            bf16_t* rowp = Kp + (size_t)(row0 + ai * HALF + m * 16) * (16 * DKP) + head * DKP + 8 * fq;
#pragma unroll
            for (int bj = 0; bj < 2; ++bj) *(u32x4*)(rowp + 32 * bj) = pack8(acc[ai][bj][m][0] * rn * g[bj][0], acc[ai][bj][m][1] * rn * g[bj][1]); }
}
struct EpiFoxIn {
    static constexpr bool PERM = true, AFTER_DRAIN = false;
    bf16_t* QK; bf16_t* Vp; bf16_t* Gt; float* lf; const float* bfg; bf16_t* Kp; const float* gk;
    __device__ __forceinline__ void operator()(const Acc& acc, const Unit& u, int wr, int wc, int fr, int fq) const {
        asm volatile("" : "+v"(fr), "+v"(fq));
        const int pn = u.pn;
        if (pn < 4) store_tile_bf16(acc, QK, 2048, u.pm * BM, pn * BM, wr, wc, fr, fq);
        else if (pn < 8) store_tile_knorm<80>(acc, Kp, gk, u.pm, pn - 4, wr, wc, fr, fq);
        else if (pn < 12) store_tile_lspace(acc, Vp, u.pm, (pn - 8) * BM, wr, wc, fr, fq);
        else if (pn < 16) store_tile_bf16(acc, Gt, 1024, u.pm * BM, (pn - 12) * BM, wr, wc, fr, fq);
        else if (wc == 0 && fq < 2) {
            const int row0 = u.pm * BM + wr * 64 + fr;
#pragma unroll
            for (int n = 0; n < 2; ++n) { const f32x4 bv = *(const f32x4*)(bfg + 8 * fq + 4 * n);
#pragma unroll
                for (int ai = 0; ai < 2; ++ai)
#pragma unroll
                    for (int m = 0; m < 4; ++m) { f32x4 z = acc[ai][0][m][n] + bv, o;
#pragma unroll
                        for (int j = 0; j < 4; ++j) o[j] = fminf(z[j], 0.f) - log1pf(expf(-fabsf(z[j])));
                        *(f32x4*)(lf + (size_t)(row0 + ai * HALF + m * 16) * 16 + 8 * fq + 4 * n) = o; } }
        }
    }
};
struct EpiKvUp {
    static constexpr bool PERM = true, AFTER_DRAIN = false;
    bf16_t* Kp; const float* gk; bf16_t* Vp;
    __device__ __forceinline__ void operator()(const Acc& acc, const Unit& u, int wr, int wc, int fr, int fq) const {
        asm volatile("" : "+v"(fr), "+v"(fq));
        if (u.pn < 4) store_tile_knorm<96>(acc, Kp, gk, u.pm, u.pn, wr, wc, fr, fq);
        else store_tile_lspace(acc, Vp, u.pm, (u.pn - 4) * BM, wr, wc, fr, fq);
    }
};
template <bool F8> struct EpiSwiglu {
    static constexpr bool PERM = true, AFTER_DRAIN = false;
    void* O; const float* ssp; float sc; int pad_;
    __device__ __forceinline__ void operator()(const Acc& acc, const Unit& u, int wr, int wc, int fr, int fq) const {
        const int row0 = u.pm * BM + wr * 64 + fr, col0 = u.pn * HALF + wc * 32 + 8 * fq;
#pragma unroll
        for (int ai = 0; ai < 2; ++ai) {
            const float ic0 = 1.0f / (sc * sc * (F8 ? F8_SH : 1.0f)); float rsv[4] = {sc, sc, sc, sc}, c0v[4] = {ic0, ic0, ic0, ic0};
            if (ssp) { f32x4 q[4][4];
#pragma unroll
                for (int m = 0; m < 4; ++m)
#pragma unroll
                    for (int k = 0; k < 4; ++k) q[m][k] = *(const f32x4*)(ssp + (size_t)(row0 + ai * HALF + m * 16) * 16 + 4 * k);
#pragma unroll
                for (int m = 0; m < 4; ++m) { float s = 0.f;
#pragma unroll
                    for (int k = 0; k < 4; ++k) s += (q[m][k][0] + q[m][k][1]) + (q[m][k][2] + q[m][k][3]);
                    const float msq = s * (1.0f / 1024.0f) + EPSN; rsv[m] = sc * __builtin_amdgcn_rsqf(msq); c0v[m] = msq * ic0; } }
#pragma unroll
            for (int m = 0; m < 4; ++m) { f32x4 o[2]; const float rs = rsv[m];
                const float k1 = -rs * LOG2E, c0 = c0v[m];
#pragma unroll
                for (int n = 0; n < 2; ++n) { const f32x4 ag = acc[ai][0][m][n], au = acc[ai][1][m][n];
#pragma unroll
                    for (int j = 0; j < 4; ++j) { const float ex = __builtin_amdgcn_exp2f(ag[j] * k1); o[n][j] = (ag[j] * au[j]) * __builtin_amdgcn_rcpf(__builtin_fmaf(ex, c0, c0)); } }
                const size_t off = (size_t)(row0 + ai * HALF + m * 16) * DFF + col0;
                if constexpr (F8) { u32x2 w; w.x = pack4_fp8(o[0][0], o[0][1], o[0][2], o[0][3]); w.y = pack4_fp8(o[1][0], o[1][1], o[1][2], o[1][3]); *(u32x2*)((unsigned char*)O + off) = w; }
                else *(u32x4*)((bf16_t*)O + off) = pack8(o[0], o[1]); } }
    }
};
template <bool WX> struct EpiResidT {
    static constexpr bool PERM = true, AFTER_DRAIN = false;
    const bf16_t* rin; bf16_t* rout; float* ssp; float sc; int pad_;
    __device__ __forceinline__ void operator()(const Acc& acc, const Unit& u, int wr, int wc, int fr, int fq) const {
        asm volatile("" : "+v"(fr), "+v"(fq));
        const int col0 = u.pn * BM + wc * 32 + 8 * fq, row0 = u.pm * BM + wr * 64 + fr;
#pragma unroll
        for (int ai = 0; ai < 2; ++ai) { u32x4 r[1][4][2];
#pragma unroll
            for (int m = 0; m < 4; ++m)
#pragma unroll
                for (int bj = 0; bj < 2; ++bj) r[0][m][bj] = *(const u32x4*)(rin + (size_t)(row0 + ai * HALF + m * 16) * 1024 + col0 + bj * HALF);
#pragma unroll
            for (int m = 0; m < 4; ++m) { const size_t off = (size_t)(row0 + ai * HALF + m * 16) * 1024 + col0; float ss = 0.f;
#pragma unroll
                for (int bj = 0; bj < 2; ++bj) { const u32x4 rr = r[0][m][bj]; const f32x4 a0 = acc[ai][bj][m][0] * sc, a1 = acc[ai][bj][m][1] * sc;
                    const f32x4 o0 = {bf_lo(rr.x) + a0[0], bf_hi(rr.x) + a0[1], bf_lo(rr.y) + a0[2], bf_hi(rr.y) + a0[3]}, o1 = {bf_lo(rr.z) + a1[0], bf_hi(rr.z) + a1[1], bf_lo(rr.w) + a1[2], bf_hi(rr.w) + a1[3]};
                    *(u32x4*)(rout + off + bj * HALF) = pack8(o0, o1);
                    if constexpr (WX) ss += ((o0[0] * o0[0] + o0[1] * o0[1]) + (o0[2] * o0[2] + o0[3] * o0[3])) + ((o1[0] * o1[0] + o1[1] * o1[1]) + (o1[2] * o1[2] + o1[3] * o1[3])); }
                if constexpr (WX) { ss += __shfl_xor(ss, 16); ss += __shfl_xor(ss, 32); if (fq == 0) ssp[(size_t)(row0 + ai * HALF + m * 16) * 16 + 4 * u.pn + wc] = ss; } }
            asm volatile("" ::: "memory"); }
    }
};
typedef int i32x8 __attribute__((ext_vector_type(8))); typedef int i32x4 __attribute__((ext_vector_type(4)));
__device__ __forceinline__ i32x8 cat8(bf16x8 a, bf16x8 b) { return __builtin_shufflevector(__builtin_bit_cast(i32x4, a), __builtin_bit_cast(i32x4, b), 0, 1, 2, 3, 4, 5, 6, 7); }
template <class Epi, class Sched, bool ALIGN_EPI = false, bool SP2 = false, bool F8 = false>
__device__ __forceinline__ void gemm_phase(PG8_LAS unsigned char* lds, const Gemm g, const Sched& S, const Epi& E) {
    int tid_ = threadIdx.x; asm volatile("" : "+v"(tid_));
    const int tid = tid_, wid = __builtin_amdgcn_readfirstlane(tid >> 6), lane = tid & 63, wr = wid >> 2, wc = wid & 3, fr = lane & 15, fq = lane >> 4;
    int K_ = g.K; asm volatile("" : "+s"(K_));     const int K = K_, nt = K / BK;
    unsigned voffA[2], voffB[2];
#pragma unroll
    for (int i = 0; i < 2; ++i) { int R, C; stage_rc(tid * 16 + i * 8192, R, C); const int Rb = Epi::PERM ? ((R & ~31) + perm32(R & 31)) : R;
        voffA[i] = (unsigned)(R * K + C) * 2u; voffB[i] = (unsigned)(Rb * K + C) * 2u; }
    const size_t kstep = (size_t)(BK * 2);
    const size_t hstep = (size_t)HALF * K * 2;
    const size_t tstep = 2 * hstep;
    const unsigned ldsw = (unsigned)wid * 1024u;
    const int aoff = lds_byte(wr * 64 + fr, fq * 8), boff = lds_byte(wc * 32 + fr, fq * 8);
#define PG8_SA(b, h) (((b) * 2 + (h)) * HTB)
#define PG8_SB(b, h) ((4 + (b) * 2 + (h)) * HTB)
#define PG8_STAGE(bufoff, gbase, voff) do { _Pragma("unroll") for (int _i = 0; _i < 2; ++_i) \
        __builtin_amdgcn_global_load_lds((const unsigned*)((const char*)(gbase) + (voff)[_i]), (PG8_LAS unsigned*)(lds + (bufoff) + ldsw + _i * 8192), 16, 0, 0); } while (0)
#define PG8_LDA(dst, b, h) do { _Pragma("unroll") for (int m = 0; m < 4; ++m) { if constexpr (F8) { dst[m] = __builtin_shufflevector(*(const PG8_LAS i32x4*)(lds + PG8_SA(b, h) + aoff + m * 2048), *(const PG8_LAS i32x4*)(lds + PG8_SA(b, h) + aoff + m * 2048 + 1024), 0, 1, 2, 3, 4, 5, 6, 7); } \
        else { _Pragma("unroll") for (int k = 0; k < 2; ++k) dst[m][k] = *(const PG8_LAS bf16x8*)(lds + PG8_SA(b, h) + aoff + m * 2048 + k * 1024); } } } while (0)
#define PG8_LDB(dst, b, h) do { _Pragma("unroll") for (int n = 0; n < 2; ++n) { if constexpr (F8) { dst[n] = __builtin_shufflevector(*(const PG8_LAS i32x4*)(lds + PG8_SB(b, h) + boff + n * 2048), *(const PG8_LAS i32x4*)(lds + PG8_SB(b, h) + boff + n * 2048 + 1024), 0, 1, 2, 3, 4, 5, 6, 7); } \
        else { _Pragma("unroll") for (int k = 0; k < 2; ++k) dst[n][k] = *(const PG8_LAS bf16x8*)(lds + PG8_SB(b, h) + boff + n * 2048 + k * 1024); } } } while (0)
#define PG8_MMA(ai, bj, At, Bt) do { __builtin_amdgcn_s_setprio(1); _Pragma("unroll") for (int m = 0; m < 4; ++m) _Pragma("unroll") for (int n = 0; n < 2; ++n) { \
        if constexpr (F8) asm volatile("v_mfma_scale_f32_16x16x128_f8f6f4 %0, %1, %2, %0, %3, %3 op_sel_hi:[0,0,0]" : "+v"(acc[ai][bj][m][n]) : "v"(Bt[n]), "v"(At[m]), "v"(f8scl));     \
        else { _Pragma("unroll") for (int k = 0; k < 2; ++k) acc[ai][bj][m][n] = __builtin_amdgcn_mfma_f32_16x16x32_bf16(Bt[n][k], At[m][k], acc[ai][bj][m][n], 0, 0, 0); } } __builtin_amdgcn_s_setprio(0); } while (0)
#define PG8_WAIT_V(n) asm volatile("s_waitcnt vmcnt(" #n ")" ::: "memory")
#define PG8_WAIT_L(n) asm volatile("s_waitcnt lgkmcnt(" #n ")" ::: "memory")
#define PG8_BAR __builtin_amdgcn_s_barrier()
#define PG8_SCHED __builtin_amdgcn_sched_barrier(0)
    Unit cur, nxt; int ui = 0;
    if (!S.next(0, cur)) return;
    f32x4 acc[2][2][4][2];
    int f8scl = 0x7F7F7F7F; asm volatile("" : "+v"(f8scl));
    using FragT = std::conditional_t<F8, i32x8, bf16x8[2]>;
    FragT At[4], B0[2], B1[2];
    const char* cA = (const char*)g.A + (size_t)cur.pm * tstep; const char* cB = (const char*)g.Bt + (size_t)cur.pb * tstep;
    S.a_ready(cur);
    if constexpr (SP2) {
        PG8_STAGE(PG8_SB(0, 0), cB, voffB); PG8_STAGE(PG8_SB(0, 1), cB + hstep, voffB); PG8_STAGE(PG8_SA(0, 0), cA, voffA); PG8_STAGE(PG8_SA(0, 1), cA + hstep, voffA);
        if (wr == 1) PG8_BAR;
        PG8_WAIT_V(2); PG8_BAR;
        PG8_STAGE(PG8_SB(1, 0), cB + kstep, voffB); PG8_STAGE(PG8_SA(1, 0), cA + kstep, voffA); PG8_STAGE(PG8_SB(1, 1), cB + hstep + kstep, voffB);
        PG8_WAIT_V(6); PG8_BAR;
    } else {
        PG8_STAGE(PG8_SB(0, 0), cB, voffB); PG8_STAGE(PG8_SA(0, 0), cA, voffA); PG8_STAGE(PG8_SB(0, 1), cB + hstep, voffB); PG8_STAGE(PG8_SA(0, 1), cA + hstep, voffA);
        if (wr == 1) PG8_BAR;
        PG8_WAIT_V(4); PG8_BAR;
        PG8_STAGE(PG8_SB(1, 0), cB + kstep, voffB); PG8_STAGE(PG8_SA(1, 0), cA + kstep, voffA); PG8_STAGE(PG8_SB(1, 1), cB + hstep + kstep, voffB);
        PG8_WAIT_V(6); PG8_BAR;
    }
    for (;;) {
#pragma unroll
        for (int a = 0; a < 2; ++a)
#pragma unroll
            for (int b = 0; b < 2; ++b)
#pragma unroll
                for (int m = 0; m < 4; ++m)
#pragma unroll
                    for (int n = 0; n < 2; ++n) acc[a][b][m][n] = (f32x4){0.f, 0.f, 0.f, 0.f};
        const bool has_next = S.next(ui + 1, nxt);
        const char* nA = has_next ? (const char*)g.A + (size_t)nxt.pm * tstep : cA; const char* nB = has_next ? (const char*)g.Bt + (size_t)nxt.pb * tstep : cB;
        int t = 0;
        do {
            const bool last = (t == nt - 2);
            const char* a1 = cA + (size_t)(t + 1) * kstep;
            const char* a2 = last ? nA : cA + (size_t)(t + 2) * kstep; const char* b2 = last ? nB : cB + (size_t)(t + 2) * kstep;
            const char* a3 = a2 + kstep; const char* b3 = b2 + kstep;
            if (last && has_next) S.a_ready(nxt);
            if constexpr (SP2) {
            PG8_LDB(B0, 0, 0); PG8_LDB(B1, 0, 1); PG8_SCHED; PG8_LDA(At, 0, 0); PG8_STAGE(PG8_SA(1, 1), a1 + hstep, voffA);
            PG8_WAIT_V(8); PG8_WAIT_L(0); PG8_BAR; PG8_MMA(0, 0, At, B0); PG8_MMA(0, 1, At, B1); PG8_BAR; PG8_SCHED;
            PG8_LDA(At, 0, 1); PG8_STAGE(PG8_SB(0, 0), b2, voffB); PG8_STAGE(PG8_SB(0, 1), b2 + hstep, voffB); PG8_STAGE(PG8_SA(0, 0), a2, voffA);
            PG8_WAIT_V(8); PG8_WAIT_L(0); PG8_BAR; PG8_MMA(1, 0, At, B0); PG8_MMA(1, 1, At, B1); PG8_BAR; PG8_SCHED;
            PG8_LDB(B0, 1, 0); PG8_LDB(B1, 1, 1); PG8_SCHED; PG8_LDA(At, 1, 0); PG8_STAGE(PG8_SA(0, 1), a2 + hstep, voffA);
            PG8_WAIT_V(8); PG8_WAIT_L(0); PG8_BAR; PG8_MMA(0, 0, At, B0); PG8_MMA(0, 1, At, B1); PG8_BAR; PG8_SCHED;
            PG8_LDA(At, 1, 1); PG8_STAGE(PG8_SB(1, 0), b3, voffB); PG8_STAGE(PG8_SB(1, 1), b3 + hstep, voffB); PG8_STAGE(PG8_SA(1, 0), a3, voffA);
            PG8_WAIT_V(8); PG8_WAIT_L(0); PG8_BAR; PG8_MMA(1, 0, At, B0); PG8_MMA(1, 1, At, B1); PG8_BAR; PG8_SCHED;
            } else {
            PG8_LDB(B0, 0, 0); PG8_SCHED; PG8_LDA(At, 0, 0); PG8_STAGE(PG8_SA(1, 1), a1 + hstep, voffA);
            PG8_WAIT_L(8); PG8_BAR; PG8_WAIT_L(0); PG8_MMA(0, 0, At, B0); PG8_BAR; PG8_SCHED;
            PG8_LDB(B1, 0, 1); PG8_STAGE(PG8_SB(0, 0), b2, voffB);
            PG8_BAR; PG8_WAIT_L(0); PG8_MMA(0, 1, At, B1); PG8_BAR;
            PG8_LDA(At, 0, 1); PG8_STAGE(PG8_SA(0, 0), a2, voffA);
            PG8_BAR; PG8_WAIT_L(0); PG8_MMA(1, 0, At, B0); PG8_BAR; PG8_SCHED;
            PG8_STAGE(PG8_SB(0, 1), b2 + hstep, voffB);
            PG8_WAIT_V(6); PG8_BAR; PG8_MMA(1, 1, At, B1); PG8_BAR;
            PG8_LDB(B0, 1, 0); PG8_SCHED; PG8_LDA(At, 1, 0); PG8_STAGE(PG8_SA(0, 1), a2 + hstep, voffA);
            PG8_WAIT_L(8); PG8_BAR; PG8_WAIT_L(0); PG8_MMA(0, 0, At, B0); PG8_BAR; PG8_SCHED;
            PG8_LDB(B1, 1, 1); PG8_STAGE(PG8_SB(1, 0), b3, voffB);
            PG8_BAR; PG8_WAIT_L(0); PG8_MMA(0, 1, At, B1); PG8_BAR;
            PG8_LDA(At, 1, 1); PG8_STAGE(PG8_SA(1, 0), a3, voffA);
            PG8_BAR; PG8_WAIT_L(0); PG8_MMA(1, 0, At, B0); PG8_BAR; PG8_SCHED;
            PG8_STAGE(PG8_SB(1, 1), b3 + hstep, voffB);
            PG8_WAIT_V(6); PG8_BAR; PG8_MMA(1, 1, At, B1); PG8_BAR;
            }
            t += 2;
        } while (t < nt);
        if constexpr (F8) asm volatile("s_nop 15\n\ts_nop 15" ::: "memory");
        if constexpr (ALIGN_EPI) { if (wr == 0) PG8_BAR; }
        if constexpr (!Epi::AFTER_DRAIN) { E(acc, cur, wr, wc, fr, fq); S.done(cur); }
        if (!has_next) break;
        cur = nxt; cA = nA; cB = nB; ++ui;
        if constexpr (ALIGN_EPI) { if (wr == 1) PG8_BAR; }
    }
    PG8_WAIT_V(0);
    if constexpr (!ALIGN_EPI) { if (wr == 0) PG8_BAR; }
    PG8_BAR;
    if constexpr (Epi::AFTER_DRAIN) { E.fused(acc, cur, wr, wc, fr, fq, lds, wid, lane); S.done(cur); }
#undef PG8_SA
#undef PG8_SB
#undef PG8_STAGE
#undef PG8_LDA
#undef PG8_LDB
#undef PG8_MMA
#undef PG8_WAIT_V
#undef PG8_WAIT_L
#undef PG8_BAR
#undef PG8_SCHED
}
}

namespace attn_body {
using s16x4=__attribute__((ext_vector_type(4)))short;
using f32x16=__attribute__((ext_vector_type(16)))float;
constexpr int NW=8,QBLK=32,QB=QBLK*NW,KVBLK=64;
__device__ __forceinline__ int crow(int r,int hi){return (r&3)+8*(r>>2)+4*hi;}
#define SBAR() __builtin_amdgcn_sched_barrier(0)
__device__ __forceinline__ void cmask(f32x16&p0,f32x16&p1,int jb,int qrel,int hi){
  const float NEG=-INFINITY; int kb=64*jb+4*hi;
  #pragma unroll
  for(int r=0;r<16;++r){int kv=kb+(r&3)+8*(r>>2); if(kv>qrel)p0[r]=NEG; if(kv+32>qrel)p1[r]=NEG;}
}
constexpr int NKSLOT=4, NVSLOT=3, VSLOTB=8192, KRING_MAX=NKSLOT*6*2048;
constexpr int LDS_K=0, LDS_V=KRING_MAX, LDS_WS=LDS_V+NVSLOT*VSLOTB, LDS_OST=LDS_WS+NW*64*4, LDS_BYTES=LDS_OST+NW*4096;
__device__ __forceinline__ void glds16(const void*gbase,unsigned voff,unsigned lds_dst){unsigned keep;
  asm volatile("s_mov_b32 %0, m0\n\ts_mov_b32 m0, %3\n\ts_nop 0\n\tglobal_load_lds_dwordx4 %1, %2\n\ts_mov_b32 m0, %0":"=&s"(keep):"v"(voff),"s"(gbase),"s"(lds_dst):"memory");}
__device__ __forceinline__ float max3f(float a,float b,float c){float r;asm("v_max3_f32 %0, %1, %2, %3":"=v"(r):"v"(a),"v"(b),"v"(c));return r;}
__device__ __forceinline__ float max2f(float a,float b){float r;asm("v_max_f32_e32 %0, %1, %2":"=v"(r):"v"(a),"v"(b));return r;}
__device__ __forceinline__ float fadd_s(float a,float b){float r;asm("v_add_f32_e32 %0, %1, %2":"=v"(r):"v"(a),"v"(b));return r;}
__device__ __forceinline__ float fsub_s(float a,float b){float r;asm("v_sub_f32_e32 %0, %1, %2":"=v"(r):"v"(a),"v"(b));return r;}
typedef float f32x2_t __attribute__((ext_vector_type(2))); typedef __bf16 bf16x2_t __attribute__((ext_vector_type(2)));
__device__ __forceinline__ unsigned cvtpk_s(float lo,float hi){f32x2_t v={lo,hi};bf16x2_t b=__builtin_convertvector(v,bf16x2_t);return __builtin_bit_cast(unsigned,b);}
__device__ __forceinline__ bf16_t f2bf_s(float x){__bf16 b=(__bf16)x;return __builtin_bit_cast(unsigned short,b);}
#define WAIT_BAR(N) asm volatile("s_waitcnt vmcnt(" #N ") lgkmcnt(0)\n\ts_barrier":::"memory")

template<int NKS> __device__ __forceinline__ void qkt(f32x16&p0,f32x16&p1,const char*Kslot,const bf16x8*qr,const f32x16&negm,int r32,int hi){
  const char*kb=Kslot+hi*1024+r32*16;
  #pragma unroll
  for(int d0=0;d0<NKS;++d0){
    const bf16x8 b0=*reinterpret_cast<const bf16x8*>(kb+d0*2048);
    const bf16x8 b1=*reinterpret_cast<const bf16x8*>(kb+d0*2048+512);
    if(d0==0){p0=__builtin_amdgcn_mfma_f32_32x32x16_bf16(b0,qr[0],negm,0,0,0);p1=__builtin_amdgcn_mfma_f32_32x32x16_bf16(b1,qr[0],negm,0,0,0);}
    else{p0=__builtin_amdgcn_mfma_f32_32x32x16_bf16(b0,qr[d0],p0,0,0,0);p1=__builtin_amdgcn_mfma_f32_32x32x16_bf16(b1,qr[d0],p1,0,0,0);}}
}
typedef __attribute__((address_space(3))) const char* lds_cptr;
typedef short v4i16_t __attribute__((ext_vector_type(4)));
#define LDSV8(p) (*(const __attribute__((address_space(3))) bf16x8*)(p))
__device__ __forceinline__ void kload8(bf16x8*kf,lds_cptr kp){
  kf[0]=LDSV8(kp);      kf[1]=LDSV8(kp+512);
  kf[2]=LDSV8(kp+2048); kf[3]=LDSV8(kp+2560);
  kf[4]=LDSV8(kp+4096); kf[5]=LDSV8(kp+4608);
  kf[6]=LDSV8(kp+6144); kf[7]=LDSV8(kp+6656);
}
__device__ __forceinline__ void kload2(bf16x8*kf,lds_cptr kp,int j){ kf[2*j]=LDSV8(kp+j*2048); kf[2*j+1]=LDSV8(kp+j*2048+512); }
__device__ __forceinline__ s16x4 vtr(lds_cptr p){ return __builtin_bit_cast(s16x4,__builtin_amdgcn_ds_read_tr16_b64_v4i16((__attribute__((address_space(3))) v4i16_t*)p)); }
__device__ __forceinline__ float rowmax(const f32x16&p0,const f32x16&p1){
  float a=max3f(p0[0],p0[1],p1[0]),b=max3f(p0[2],p0[3],p1[1]);a=max3f(a,p1[2],p1[3]);
  #pragma unroll
  for(int r=4;r<16;r+=4){a=max3f(a,p0[r],p0[r+1]);b=max3f(b,p0[r+2],p0[r+3]);a=max3f(a,p1[r],p1[r+1]);b=max3f(b,p1[r+2],p1[r+3]);}
  const float m=max2f(a,b);
  auto rr=__builtin_amdgcn_permlane32_swap(__float_as_uint(m),__float_as_uint(m),false,false);
  return max2f(__uint_as_float(rr[0]),__uint_as_float(rr[1]));
}
__device__ __forceinline__ float pair_sum(float v){ auto rr=__builtin_amdgcn_permlane32_swap(__float_as_uint(v),__float_as_uint(v),false,false); return __uint_as_float(rr[0])+__uint_as_float(rr[1]); }
__device__ __forceinline__ void pv(f32x16*o,int vb,bf16x8 pa0,bf16x8 pa1,bf16x8 pa2,bf16x8 pa3){
  #pragma unroll
  for(int d0=0;d0<2;++d0){s16x4 lo[4],hi[4];
    #pragma unroll
    for(int ks=0;ks<4;++ks){
      asm volatile("ds_read_b64_tr_b16 %0,%1 offset:%c2":"=&v"(lo[ks]):"v"(vb),"i"(d0*4096+ks*1024):"memory");
      asm volatile("ds_read_b64_tr_b16 %0,%1 offset:%c2":"=&v"(hi[ks]):"v"(vb),"i"(d0*4096+ks*1024+512):"memory");}
    asm volatile("s_waitcnt lgkmcnt(0)":::"memory");SBAR();
    #define PK(k) (bf16x8){lo[k][0],lo[k][1],lo[k][2],lo[k][3],hi[k][0],hi[k][1],hi[k][2],hi[k][3]}
    o[d0]=__builtin_amdgcn_mfma_f32_32x32x16_bf16(pa0,PK(0),o[d0],0,0,0);
    o[d0]=__builtin_amdgcn_mfma_f32_32x32x16_bf16(pa1,PK(1),o[d0],0,0,0);
    o[d0]=__builtin_amdgcn_mfma_f32_32x32x16_bf16(pa2,PK(2),o[d0],0,0,0);
    o[d0]=__builtin_amdgcn_mfma_f32_32x32x16_bf16(pa3,PK(3),o[d0],0,0,0);
    #undef PK
  }
}
struct AttnArgs { const bf16_t* Q; const bf16_t* K; const bf16_t* V; bf16_t* O; const bf16_t* G; const float* gq; const float* ctab; const float* rope; };

template<int NKS,int MODE,int THRL,bool FIXREF> __device__ __forceinline__ void attn_unit(int b,int h,int qb,const AttnArgs&T,char*shm){
  constexpr int DKP=16*NKS, KP=16*DKP, KSLOT=NKS*2048, NX=2*NKS-8, NQ=(MODE==0)?4:6, DQ=NQ*16, QP=(MODE==0)?2048:1536;
  static_assert(NKS==5||NKS==6,"NKS"); static_assert((MODE==0&&NKS==5)||(MODE==1&&NKS==6),"mode/NKS");
  int tid_=threadIdx.x; asm volatile("":"+v"(tid_)); const int tid=tid_,lane=tid&63,r32=lane&31,hi=lane>>5; const int wid=__builtin_amdgcn_readfirstlane(tid>>6);
  const bf16_t*Kh_=T.K+(size_t)b*LP*KP+h*DKP,*Vh_=T.V+(size_t)b*LP*1024+h*64; const int q0=qb*QB; const bf16_t*Kh=Kh_,*Vh=Vh_;
  int NT=(q0+QB)/KVBLK;
  if constexpr(MODE==0){
    constexpr float FOX_SKIP=50.f;
    const float cq0=T.ctab[(size_t)lpos_to_row(b,q0)*16+h];
    int nskip=0;
    #pragma unroll
    for(int i=0;i<3;++i){ const int j=lane+64*i; bool sk=false;
      if(j<NT){ const int p=64*j+63; const float ce=T.ctab[(size_t)lpos_to_row(b,p<LVALID?p:LVALID-1)*16+h]; sk=(ce>cq0+FOX_SKIP); }
      nskip+=__builtin_popcountll(__ballot(sk)); }
    int ts=nskip&~1; if(ts>NT-4)ts=NT-4; ts=__builtin_amdgcn_readfirstlane(ts);
    NT-=ts; Kh+=(size_t)ts*KVBLK*KP; Vh+=(size_t)ts*KVBLK*1024;
  }
  const unsigned lds0=(unsigned)(uintptr_t)shm;
  float*wsf=(float*)(shm+LDS_WS)+wid*64;
  const int c2=8+(wid&(NX-1));
  const unsigned kvoff=(unsigned)lane*(KP*2), vvoff=(unsigned)((lane>>2)*2048+(lane&3)*16);
  const char*kbase1=(const char*)(Kh+wid*8),*kbase2=(const char*)(Kh+c2*8),*vbase=(const char*)(Vh+(size_t)(16*(wid&3))*1024+(wid>>2)*32);
  const unsigned kdst=lds0+LDS_K+wid*1024, kdst2=lds0+LDS_K+c2*1024, vdst=lds0+LDS_V+wid*1024;
  #define DMA_K(t,slot) do{ glds16(kbase1+(size_t)(t)*(KVBLK*KP*2),kvoff,(unsigned)__builtin_amdgcn_readfirstlane(kdst+(slot))); glds16(kbase2+(size_t)(t)*(KVBLK*KP*2),kvoff,(unsigned)__builtin_amdgcn_readfirstlane(kdst2+(slot))); }while(0)
  #define DMA_V(t,slot) glds16(vbase+(size_t)(t)*(KVBLK*2048),vvoff,(unsigned)__builtin_amdgcn_readfirstlane(vdst+(slot)))
  const int vb0=(int)(lds0+LDS_V)+((lane>>4)&1)*32+(lane&3)*8+(4*hi+((lane&15)>>2))*64;
  const char*Kbase=shm+LDS_K; bf16x8 kf[8];
  const lds_cptr shm3=(lds_cptr)shm; const lds_cptr kp0=shm3+LDS_K+hi*1024+r32*16; const lds_cptr vp0=shm3+LDS_V+((lane>>4)&1)*32+(lane&3)*8+(4*hi+((lane&15)>>2))*64;
  DMA_K(0,0);DMA_V(0,0);DMA_K(1,KSLOT);
  bf16x8 qr[NKS];
  {
    const int pos=q0+wid*QBLK+r32, posc=pos<LVALID?pos:LVALID-1;
    const int rq=lpos_to_row(b,posc);
    const bf16_t*qp=T.Q+(size_t)rq*QP+h*DQ+hi*8;
    u32x4 raw[NQ]; float xf[NQ][8]; float ss=0.f;
    #pragma unroll
    for(int d0=0;d0<NQ;++d0)raw[d0]=*(const u32x4*)(qp+d0*16);
    #pragma unroll
    for(int d0=0;d0<NQ;++d0){
      #pragma unroll
      for(int j=0;j<4;++j){const unsigned w=raw[d0][j]; xf[d0][2*j]=bf_lo(w); xf[d0][2*j+1]=bf_hi(w); ss+=xf[d0][2*j]*xf[d0][2*j]+xf[d0][2*j+1]*xf[d0][2*j+1];}}
    ss=pair_sum(ss);
    const float C2F=((MODE==0)?0.125f:0.10206207261596575f)*LOG2E;
    const float rn=__builtin_amdgcn_rsqf(ss*(1.0f/DQ)+EPSN);
    #pragma unroll
    for(int d0=0;d0<NQ;++d0){const f32x4 g0=*(const f32x4*)(T.gq+d0*16+hi*8),g1=*(const f32x4*)(T.gq+d0*16+hi*8+4);
      #pragma unroll
      for(int j=0;j<4;++j){xf[d0][j]*=rn*g0[j]; xf[d0][4+j]*=rn*g1[j];}}
    if constexpr(MODE==1){
      const float*rp=T.rope+(size_t)(b*LP+posc)*32+hi*8;
      const f32x4 c0=*(const f32x4*)(rp),c1=*(const f32x4*)(rp+4),s0=*(const f32x4*)(rp+16),s1=*(const f32x4*)(rp+20);
      #pragma unroll
      for(int j=0;j<8;++j){const float c=j<4?c0[j&3]:c1[j&3],s=j<4?s0[j&3]:s1[j&3]; const float x1=xf[4][j],x2=xf[5][j]; xf[4][j]=x1*c-x2*s; xf[5][j]=x2*c+x1*s;}
    }
    #pragma unroll
    for(int d0=0;d0<NQ;++d0){u32x4 w;
      #pragma unroll
      for(int j=0;j<4;++j)w[j]=cvtpk_s(xf[d0][2*j]*C2F,xf[d0][2*j+1]*C2F);
      qr[d0]=__builtin_bit_cast(bf16x8,w);}
    if constexpr(MODE==0){
      const float cq=T.ctab[(size_t)rq*16+h]*LOG2E;
      const bf16_t h1=f2bf_s(cq); const float f1=bf2f(h1); const bf16_t h2=f2bf_s(cq-f1); const float f2=bf2f(h2); const bf16_t h3=f2bf_s(cq-f1-f2);
      u32x4 w; w.x=0x3F803F80u; w.y=0x3F80u|((unsigned)h1<<16); w.z=(unsigned)h2|((unsigned)h3<<16); w.w=0u;
      if(hi)w=(u32x4){0u,0u,0u,0u};
      qr[4]=__builtin_bit_cast(bf16x8,w);
    }
  }
  float mhat=0.f,l_reg=0.f;f32x16 o[2];o[0]=f32x16{};o[1]=f32x16{};f32x16 negm=f32x16{};if constexpr(!FIXREF)asm volatile("":"+v"(negm));
  const int qrel=wid*QBLK+r32;
  #define CMASK(P0,P1,t) do{int jb_=(t)-(NT-4); if(jb_>=0)cmask(P0,P1,jb_,qrel,hi);}while(0)
  bool resc=false;
  #define START(P0,P1) do{ if constexpr(!FIXREF){ const float rm=rowmax(P0,P1); resc=false; \
    { const float dl=rm; mhat=fadd_s(mhat,dl); \
      _Pragma("unroll") for(int r=0;r<16;++r){P0[r]=fsub_s(P0[r],dl);P1[r]=fsub_s(P1[r],dl);} \
      _Pragma("unroll") for(int r=0;r<16;++r)negm[r]=-mhat; asm volatile("":"+v"(negm)); } } \
    _Pragma("unroll") for(int r=0;r<16;++r)P0[r]=__builtin_amdgcn_exp2f(P0[r]); }while(0)
  #define RESC() do{ if constexpr(!FIXREF){ if(resc){ asm volatile("s_waitcnt lgkmcnt(0)":::"memory"); \
      _Pragma("unroll") for(int d_=0;d_<2;++d_) _Pragma("unroll") for(int r=0;r<16;++r)o[d_][r]*=wsf[crow(r,hi)]; } } }while(0)
  f32x16 pA0,pA1,pB0,pB1;
  int ks_prev=0,ks_cur=0,ks_next=KSLOT;
  int vs_prev=0,vs_cur=0,vs_next=VSLOTB;
  #define ROT() do{ks_prev=ks_cur;ks_cur=ks_next;ks_next=(ks_next==(NKSLOT-1)*KSLOT)?0:ks_next+KSLOT; vs_prev=vs_cur;vs_cur=vs_next;vs_next=(vs_next==(NVSLOT-1)*VSLOTB)?0:vs_next+VSLOTB;}while(0)
  DMA_K(2,2*KSLOT);
  WAIT_BAR(5);
  qkt<NKS>(pA0,pA1,Kbase,qr,negm,r32,hi);asm volatile("s_nop 15\n\ts_nop 7":"+v"(pA0),"+v"(pA1));CMASK(pA0,pA1,0);
  START(pA0,pA1);
  _Pragma("unroll") for(int r=0;r<16;++r)pA1[r]=__builtin_amdgcn_exp2f(pA1[r]);
  WAIT_BAR(0);
  DMA_K(3,3*KSLOT);DMA_V(1,VSLOTB);
  ROT();
  kload8(kf,kp0+ks_cur);
  s16x4 vlo[8],vhi[8]; u32x4 pw0,pw1,pw2,pw3;
  #define PKW(P,B) cvtpk_s(P[B],P[B+1])
  #define PAF(k) __builtin_bit_cast(bf16x8,pw##k)
  #define VFR(i) (bf16x8){vlo[i][0],vlo[i][1],vlo[i][2],vlo[i][3],vhi[i][0],vhi[i][1],vhi[i][2],vhi[i][3]}
  #define PIN(x) asm volatile("":"+v"(x))
  #define MX3(a,b,c) __builtin_fmaxf(__builtin_fmaxf((a),(b)),(c))
  #define GAPA(MF,A0,A1,A2,A3,W0,W1,PW) do{ MF; sacc+=A0; sacc+=A1; sacc+=A2; sacc+=A3; PIN(sacc); W0; W1; PIN(PW); SBAR(); }while(0)
  #define EX(v) __builtin_amdgcn_exp2f(v)
  #define GAPB(MF,X,B) do{ MF; X[B]=EX(X[B]); X[B+1]=EX(X[B+1]); X[B+2]=EX(X[B+2]); X[B+3]=EX(X[B+3]); PIN(X); SBAR(); }while(0)
  #define VRD(i) do{ vlo[i]=vtr(vp_+(((i)>>2)*4096+((i)&3)*1024)); vhi[i]=vtr(vp_+(((i)>>2)*4096+((i)&3)*1024+512)); }while(0)
  #define KRD(G,j) do{ if(G){ kload2(kf,kp0+ks_next,j); SBAR(); } }while(0)
  #define XKRD() do{ const lds_cptr kx_=kp0+ks_cur; kf[0]=LDSV8(kx_+4*2048); kf[1]=LDSV8(kx_+4*2048+512); if constexpr(NKS>5){ kf[2]=LDSV8(kx_+5*2048); kf[3]=LDSV8(kx_+5*2048+512); } SBAR(); }while(0)
  #define XMMA(C0,C1) do{ C0=__builtin_amdgcn_mfma_f32_32x32x16_bf16(kf[0],qr[4],C0,0,0,0); C1=__builtin_amdgcn_mfma_f32_32x32x16_bf16(kf[1],qr[4],C1,0,0,0); \
    if constexpr(NKS>5){ C0=__builtin_amdgcn_mfma_f32_32x32x16_bf16(kf[2],qr[5],C0,0,0,0); C1=__builtin_amdgcn_mfma_f32_32x32x16_bf16(kf[3],qr[5],C1,0,0,0); } SBAR(); }while(0)
  #define STEP(C0,C1,P0,P1,t,GK,GV,GL) do{ SBAR(); \
    const lds_cptr vp_=vp0+vs_prev; \
    float sacc=(P0[0]+P0[1]); \
      \
    if constexpr(NKS>5){ \
      VRD(0); SBAR(); C0=__builtin_amdgcn_mfma_f32_32x32x16_bf16(kf[0],qr[0],negm,0,0,0); sacc+=P0[2]; sacc+=P0[3]; sacc+=P0[4]; PIN(sacc); pw0[0]=PKW(P0,0); PIN(pw0); SBAR(); \
      VRD(4); SBAR(); C1=__builtin_amdgcn_mfma_f32_32x32x16_bf16(kf[1],qr[0],negm,0,0,0); sacc+=P0[5]; sacc+=P0[6]; sacc+=P0[7]; PIN(sacc); pw0[1]=PKW(P0,2); PIN(pw0); SBAR(); \
      VRD(1); SBAR(); C0=__builtin_amdgcn_mfma_f32_32x32x16_bf16(kf[2],qr[1],C0,0,0,0); sacc+=P0[8]; sacc+=P0[9]; sacc+=P0[10]; PIN(sacc); pw0[2]=PKW(P0,4); PIN(pw0); SBAR(); \
      VRD(5); SBAR(); C1=__builtin_amdgcn_mfma_f32_32x32x16_bf16(kf[3],qr[1],C1,0,0,0); sacc+=P0[11]; sacc+=P0[12]; sacc+=P0[13]; PIN(sacc); pw0[3]=PKW(P0,6); PIN(pw0); SBAR(); \
      XKRD(); \
      VRD(2); SBAR(); C0=__builtin_amdgcn_mfma_f32_32x32x16_bf16(kf[4],qr[2],C0,0,0,0); sacc+=P0[14]; sacc+=P0[15]; sacc+=P1[0]; PIN(sacc); pw1[0]=PKW(P0,8); PIN(pw1); SBAR(); \
      VRD(6); SBAR(); C1=__builtin_amdgcn_mfma_f32_32x32x16_bf16(kf[5],qr[2],C1,0,0,0); sacc+=P1[1]; sacc+=P1[2]; sacc+=P1[3]; PIN(sacc); pw1[1]=PKW(P0,10); PIN(pw1); SBAR(); \
      VRD(3); SBAR(); C0=__builtin_amdgcn_mfma_f32_32x32x16_bf16(kf[6],qr[3],C0,0,0,0); sacc+=P1[4]; sacc+=P1[5]; PIN(sacc); pw1[2]=PKW(P0,12); pw1[3]=PKW(P0,14); PIN(pw1); SBAR(); \
      VRD(7); SBAR(); C1=__builtin_amdgcn_mfma_f32_32x32x16_bf16(kf[7],qr[3],C1,0,0,0); sacc+=P1[6]; sacc+=P1[7]; PIN(sacc); pw2[0]=PKW(P1,0); pw2[1]=PKW(P1,2); PIN(pw2); SBAR(); \
      C0=__builtin_amdgcn_mfma_f32_32x32x16_bf16(kf[0],qr[4],C0,0,0,0); sacc+=P1[8]; sacc+=P1[9]; PIN(sacc); pw2[2]=PKW(P1,4); pw2[3]=PKW(P1,6); PIN(pw2); SBAR(); \
      C1=__builtin_amdgcn_mfma_f32_32x32x16_bf16(kf[1],qr[4],C1,0,0,0); sacc+=P1[10]; sacc+=P1[11]; PIN(sacc); pw3[0]=PKW(P1,8); pw3[1]=PKW(P1,10); PIN(pw3); SBAR(); \
      C0=__builtin_amdgcn_mfma_f32_32x32x16_bf16(kf[2],qr[5],C0,0,0,0); sacc+=P1[12]; sacc+=P1[13]; PIN(sacc); pw3[2]=PKW(P1,12); PIN(pw3); SBAR(); \
      C1=__builtin_amdgcn_mfma_f32_32x32x16_bf16(kf[3],qr[5],C1,0,0,0); sacc+=P1[14]; sacc+=P1[15]; PIN(sacc); pw3[3]=PKW(P1,14); PIN(pw3); SBAR(); \
    } else { \
      VRD(0); SBAR(); C0=__builtin_amdgcn_mfma_f32_32x32x16_bf16(kf[0],qr[0],negm,0,0,0); sacc+=P0[2]; sacc+=P0[3]; sacc+=P0[4]; PIN(sacc); pw0[0]=PKW(P0,0); PIN(pw0); SBAR(); \
      VRD(4); SBAR(); C1=__builtin_amdgcn_mfma_f32_32x32x16_bf16(kf[1],qr[0],negm,0,0,0); sacc+=P0[5]; sacc+=P0[6]; sacc+=P0[7]; PIN(sacc); pw0[1]=PKW(P0,2); PIN(pw0); SBAR(); \
      VRD(1); SBAR(); C0=__builtin_amdgcn_mfma_f32_32x32x16_bf16(kf[2],qr[1],C0,0,0,0); sacc+=P0[8]; sacc+=P0[9]; sacc+=P0[10]; PIN(sacc); pw0[2]=PKW(P0,4); PIN(pw0); SBAR(); \
      VRD(5); SBAR(); C1=__builtin_amdgcn_mfma_f32_32x32x16_bf16(kf[3],qr[1],C1,0,0,0); sacc+=P0[11]; sacc+=P0[12]; sacc+=P0[13]; PIN(sacc); pw0[3]=PKW(P0,6); PIN(pw0); SBAR(); \
      XKRD(); \
      VRD(2); SBAR(); C0=__builtin_amdgcn_mfma_f32_32x32x16_bf16(kf[4],qr[2],C0,0,0,0); sacc+=P0[14]; sacc+=P0[15]; sacc+=P1[0]; PIN(sacc); pw1[0]=PKW(P0,8); pw1[1]=PKW(P0,10); PIN(pw1); SBAR(); \
      VRD(6); SBAR(); C1=__builtin_amdgcn_mfma_f32_32x32x16_bf16(kf[5],qr[2],C1,0,0,0); sacc+=P1[1]; sacc+=P1[2]; sacc+=P1[3]; PIN(sacc); pw1[2]=PKW(P0,12); pw1[3]=PKW(P0,14); PIN(pw1); SBAR(); \
      VRD(3); SBAR(); C0=__builtin_amdgcn_mfma_f32_32x32x16_bf16(kf[6],qr[3],C0,0,0,0); sacc+=P1[4]; sacc+=P1[5]; sacc+=P1[6]; PIN(sacc); pw2[0]=PKW(P1,0); pw2[1]=PKW(P1,2); PIN(pw2); SBAR(); \
      VRD(7); SBAR(); C1=__builtin_amdgcn_mfma_f32_32x32x16_bf16(kf[7],qr[3],C1,0,0,0); sacc+=P1[7]; sacc+=P1[8]; sacc+=P1[9]; PIN(sacc); pw2[2]=PKW(P1,4); pw2[3]=PKW(P1,6); PIN(pw2); SBAR(); \
      C0=__builtin_amdgcn_mfma_f32_32x32x16_bf16(kf[0],qr[4],C0,0,0,0); sacc+=P1[10]; sacc+=P1[11]; sacc+=P1[12]; PIN(sacc); pw3[0]=PKW(P1,8); pw3[1]=PKW(P1,10); PIN(pw3); SBAR(); \
      C1=__builtin_amdgcn_mfma_f32_32x32x16_bf16(kf[1],qr[4],C1,0,0,0); sacc+=P1[13]; sacc+=P1[14]; sacc+=P1[15]; PIN(sacc); pw3[2]=PKW(P1,12); pw3[3]=PKW(P1,14); PIN(pw3); SBAR(); \
    } \
    l_reg+=sacc; \
    if(GK){DMA_K((t)+3,ks_prev);} if(GV){DMA_V((t)+1,vs_next);} \
    CMASK(C0,C1,t); \
    if constexpr(!FIXREF){ float a=MX3(C0[0],C0[1],C1[0]),b=MX3(C0[2],C0[3],C1[1]); a=MX3(a,C1[2],C1[3]); \
      _Pragma("unroll") for(int r=4;r<16;r+=4){a=MX3(a,C0[r],C0[r+1]);b=MX3(b,C0[r+2],C0[r+3]);a=MX3(a,C1[r],C1[r+1]);b=MX3(b,C1[r+2],C1[r+3]);} \
      float rm=__builtin_fmaxf(a,b); { auto rr=__builtin_amdgcn_permlane32_swap(__float_as_uint(rm),__float_as_uint(rm),false,false); rm=__builtin_fmaxf(__uint_as_float(rr[0]),__uint_as_float(rr[1])); } \
      resc=false; \
      if(__builtin_expect(__any(rm>(float)THRL),0)){ const float dl=__builtin_fmaxf(rm,0.f); mhat+=dl; \
        _Pragma("unroll") for(int r=0;r<16;++r){C0[r]-=dl;C1[r]-=dl;} \
        _Pragma("unroll") for(int r=0;r<16;++r)negm[r]=-mhat; asm volatile("":"+v"(negm)); \
        const float f=__builtin_amdgcn_exp2f(-dl); l_reg*=f; if(hi==0)wsf[r32]=f; resc=true; } } \
    SBAR(); \
    GAPB(o[0]=__builtin_amdgcn_mfma_f32_32x32x16_bf16(PAF(0),VFR(0),o[0],0,0,0), C0,0); \
    GAPB(o[1]=__builtin_amdgcn_mfma_f32_32x32x16_bf16(PAF(0),VFR(4),o[1],0,0,0), C0,4); \
    KRD(GL,0); GAPB(o[0]=__builtin_amdgcn_mfma_f32_32x32x16_bf16(PAF(1),VFR(1),o[0],0,0,0), C0,8); \
    KRD(GL,1); GAPB(o[1]=__builtin_amdgcn_mfma_f32_32x32x16_bf16(PAF(1),VFR(5),o[1],0,0,0), C0,12); \
    KRD(GL,2); GAPB(o[0]=__builtin_amdgcn_mfma_f32_32x32x16_bf16(PAF(2),VFR(2),o[0],0,0,0), C1,0); \
    KRD(GL,3); GAPB(o[1]=__builtin_amdgcn_mfma_f32_32x32x16_bf16(PAF(2),VFR(6),o[1],0,0,0), C1,4); \
    GAPB(o[0]=__builtin_amdgcn_mfma_f32_32x32x16_bf16(PAF(3),VFR(3),o[0],0,0,0), C1,8); \
    GAPB(o[1]=__builtin_amdgcn_mfma_f32_32x32x16_bf16(PAF(3),VFR(7),o[1],0,0,0), C1,12); \
    }while(0)
  int t=1;
  #undef CMASK
  #define CMASK(P0,P1,t) do{}while(0)
  for(;t+5<NT;t+=2){
    STEP(pB0,pB1,pA0,pA1,t,true,true,true);     WAIT_BAR(3); RESC(); ROT();
    STEP(pA0,pA1,pB0,pB1,t+1,true,true,true);   WAIT_BAR(3); RESC(); ROT();
  }
  #undef CMASK
  #define CMASK(P0,P1,t) do{int jb_=(t)-(NT-4); if(jb_>=0)cmask(P0,P1,jb_,qrel,hi);}while(0)
  #define ENDW(tt) do{ if((tt)+3<NT){WAIT_BAR(3);} else if((tt)+2<NT){WAIT_BAR(1);} else {WAIT_BAR(0);} }while(0)
  for(;t+1<NT;t+=2){
    STEP(pB0,pB1,pA0,pA1,t,(t+3<NT),(t+1<NT),(t+1<NT));       ENDW(t);   RESC(); ROT();
    STEP(pA0,pA1,pB0,pB1,t+1,(t+4<NT),(t+2<NT),(t+2<NT));     ENDW(t+1); RESC(); ROT();
  }
  STEP(pB0,pB1,pA0,pA1,NT-1,false,false,false); RESC();
  { float sacc=pB0[0]+pB0[1]; _Pragma("unroll") for(int r=2;r<16;++r)sacc+=pB0[r]; _Pragma("unroll") for(int r=0;r<16;++r)sacc+=pB1[r]; l_reg+=sacc;
    pw0=(u32x4){PKW(pB0,0),PKW(pB0,2),PKW(pB0,4),PKW(pB0,6)};pw1=(u32x4){PKW(pB0,8),PKW(pB0,10),PKW(pB0,12),PKW(pB0,14)};pw2=(u32x4){PKW(pB1,0),PKW(pB1,2),PKW(pB1,4),PKW(pB1,6)};pw3=(u32x4){PKW(pB1,8),PKW(pB1,10),PKW(pB1,12),PKW(pB1,14)};
    SBAR(); pv(o,vb0+vs_cur,PAF(0),PAF(1),PAF(2),PAF(3)); }
  #undef PKW
  #undef PAF
  #undef VFR
  #undef PIN
  #undef MX3
  #undef GAPA
  #undef GAPB
  #undef EX
  #undef VRD
  #undef KRD
  #undef XKRD
  #undef XMMA
  #undef STEP
  #undef ENDW
  u32x4 gpre[4]={};
  if constexpr(MODE==0){
    #pragma unroll
    for(int i=0;i<4;++i){const int row=i*8+(lane>>3),ch=lane&7; const int p=q0+wid*QBLK+row;
      gpre[i]=*(const u32x4*)(T.G+(size_t)lpos_to_row(b,p<LVALID?p:LVALID-1)*1024+h*64+ch*8);} }
  l_reg=pair_sum(l_reg);
  if(hi==0)wsf[32+r32]=l_reg;asm volatile("s_waitcnt lgkmcnt(0)":::"memory");
  float rli[16];
  #pragma unroll
  for(int r=0;r<16;++r)rli[r]=__builtin_amdgcn_rcpf(wsf[32+crow(r,hi)]);
  { bf16_t*stg=(bf16_t*)(shm+LDS_OST)+wid*2048;
    #pragma unroll
    for(int r=0;r<16;++r){const int orow=crow(r,hi);
      #pragma unroll
      for(int d0=0;d0<2;++d0)stg[orow*64+d0*32+r32]=f2bf_s(o[d0][r]*rli[r]);}
    asm volatile("s_waitcnt lgkmcnt(0)":::"memory");
    #pragma unroll
    for(int i=0;i<4;++i){const int row=i*8+(lane>>3),ch=lane&7; u32x4 v=*(const u32x4*)(stg+row*64+ch*8);
      const int p=q0+wid*QBLK+row; const bool ok=p<LVALID&&(p>=NMETA||b==0);
      const size_t off=(size_t)lpos_to_row(b,p<LVALID?p:LVALID-1)*1024+h*64+ch*8;
      if constexpr(MODE==0){ const u32x4 g=gpre[i];
        #pragma unroll
        for(int j=0;j<4;++j)v[j]=cvtpk_s(bf_lo(v[j])*fast_sigmoid(bf_lo(g[j])),bf_hi(v[j])*fast_sigmoid(bf_hi(g[j]))); }
      if(ok)*(u32x4*)(T.O+off)=v; } }
  asm volatile("s_waitcnt lgkmcnt(0)\n\ts_barrier":::"memory");
  #undef DMA_K
  #undef DMA_V
  #undef CMASK
  #undef START
  #undef RESC
  #undef ROT
}
template<int MODE> __device__ __forceinline__ bool attn_fixref_ok(const float*gq,const float*gk,const float*gk2,int lane){
  float a,b,c=0.f;
  if constexpr(MODE==0){ a=fabsf(gq[lane]); b=fabsf(gk[lane]); }
  else{ a=fmaxf(fabsf(gq[lane]),fabsf(gq[64+(lane&31)])); b=fabsf(gk[lane]); c=fabsf(gk2[lane&31]); }
  #pragma unroll
  for(int s=1;s<64;s<<=1){ a=fmaxf(a,__shfl_xor(a,s)); b=fmaxf(b,__shfl_xor(b,s)); c=fmaxf(c,__shfl_xor(c,s)); }
  const float bound=(MODE==0)?(0.125f*LOG2E*64.f)*a*b:LOG2E*a*sqrtf(64.f*b*b+32.f*c*c);
  const float bu=__uint_as_float(__builtin_amdgcn_readfirstlane(__float_as_uint(bound*1.05f+1.0f)));
  return bu<=60.f;
}
template<int NKS,int MODE,int THRL,bool FIXREF> __device__ __forceinline__ void attn_phase(char*lds,const AttnArgs&T,unsigned*qctr){
  volatile int*slot=(volatile int*)(lds+LDS_BYTES);
  const int tid=threadIdx.x;
  if(tid==0)*slot=(int)__hip_atomic_fetch_add(qctr,1u,__ATOMIC_RELAXED,__HIP_MEMORY_SCOPE_AGENT);
  __syncthreads();
  for(;;){ const int u=__builtin_amdgcn_readfirstlane(*slot); if(u>=64*33)break;
    int nxt=0; if(tid==0)nxt=(int)__hip_atomic_fetch_add(qctr,1u,__ATOMIC_RELAXED,__HIP_MEMORY_SCOPE_AGENT);
    __syncthreads();
    const int bh=u&63,qb=32-(u>>6);
    attn_unit<NKS,MODE,THRL,FIXREF>(bh>>4,bh&15,qb,T,lds);
    if(tid==0)*slot=nxt;
    __syncthreads(); }
}
#undef SBAR
#undef WAIT_BAR
#undef LDSV8
}
typedef GAS unsigned gu32;
typedef GAS unsigned long long gu64;
#define RLX_AGENT __ATOMIC_RELAXED, __HIP_MEMORY_SCOPE_AGENT
#define LDS_WAIT() asm volatile("s_waitcnt lgkmcnt(0)" ::: "memory")
#define VM_WAIT() asm volatile("s_waitcnt vmcnt(0)" ::: "memory")
#define XB_TMO      128
#define XB_XCNT(j)  (256  + 64 * (j))
#define XB_XSUB(j)  (1280 + 64 * (j))
#define XB_XGEN(j)  (2304 + 64 * (j))
#define XB_TOP      3328
#define XB_TOPGEN   3392
#define XCD_BAR_WORDS 3456
#define XB_SPIN_CAP (1u << 18)

__device__ __forceinline__ unsigned xb_ld(unsigned* p)              { return __hip_atomic_load(p, __ATOMIC_RELAXED, __HIP_MEMORY_SCOPE_AGENT); }
__device__ __forceinline__ unsigned xb_add(unsigned* p, unsigned v) { return __hip_atomic_fetch_add(p, v, __ATOMIC_RELAXED, __HIP_MEMORY_SCOPE_AGENT); }
__device__ __forceinline__ unsigned xb_xcc_id() { return (unsigned)__builtin_amdgcn_s_getreg((3 << 11) | 20) & 0xFu; }
#define XB_SPIN(cond, bar) do { unsigned _sp = 0; while (cond) { __builtin_amdgcn_s_sleep(1); \
    if ((++_sp & 255u) == 0u) { if (xb_ld(&(bar)[XB_TMO])) break; if (_sp > XB_SPIN_CAP) { atomicAdd(&(bar)[XB_TMO], 1u); break; } } } } while (0)

struct XcdBarrier {
    unsigned* bar; unsigned x;
    volatile LAS unsigned* st;
};

__device__ __forceinline__ XcdBarrier xcd_barrier_post(unsigned* bar, volatile LAS unsigned* st) {
    XcdBarrier b; b.bar = bar; b.x = xb_xcc_id(); b.st = st;
    if (threadIdx.x == 0) (void)xb_add(&bar[XB_XCNT(b.x)], 1u);
    return b;
}
__device__ __forceinline__ void xcd_barrier_complete(unsigned* bar, unsigned x, unsigned& nloc, unsigned& nx) {
    const unsigned G = gridDim.x * gridDim.y * gridDim.z;
    unsigned sum, cnt, mine, sp = 0u;
    for (;;) {
        sum = 0u; cnt = 0u; mine = 0u;
#pragma unroll
        for (unsigned j = 0; j < 16; ++j) { const unsigned c = xb_ld(&bar[XB_XCNT(j)]); sum += c; cnt += (c > 0u) ? 1u : 0u; mine = (j == x) ? c : mine; }
        if (sum == G) break;
        __builtin_amdgcn_s_sleep(1);
        if ((++sp & 255u) == 0u) { if (xb_ld(&bar[XB_TMO])) break; if (sp > XB_SPIN_CAP) { atomicAdd(&bar[XB_TMO], 1u); break; } }
    }
    nloc = mine > 0u ? mine : 1u; nx = cnt > 0u ? cnt : 1u;
}

__device__ __forceinline__ void xcd_barrier(const XcdBarrier& b) {
    asm volatile("s_waitcnt vmcnt(0)" ::: "memory");
    __syncthreads();
    if (threadIdx.x == 0) {
        unsigned* bar = b.bar;
        __builtin_amdgcn_s_waitcnt(0);
        unsigned nloc = b.st[0], nx = b.st[1];
        if (nloc == 0u) { xcd_barrier_complete(bar, b.x, nloc, nx); b.st[0] = nloc; b.st[1] = nx; }
        const unsigned old = xb_add(&bar[XB_XSUB(b.x)], 1u);
        const unsigned gen = old / nloc;
        if (old + 1u == (gen + 1u) * nloc) {
            __builtin_amdgcn_fence(__ATOMIC_RELEASE, "agent");
            asm volatile("s_waitcnt vmcnt(0)" ::: "memory");
            const unsigned og = xb_add(&bar[XB_TOP], 1u);
            const unsigned tg = og / nx;
            if (og + 1u == (tg + 1u) * nx) xb_add(&bar[XB_TOPGEN], 1u);
            else XB_SPIN(xb_ld(&bar[XB_TOPGEN]) == tg, bar);
            __builtin_amdgcn_fence(__ATOMIC_ACQUIRE, "agent");
            xb_add(&bar[XB_XGEN(b.x)], 1u);
            asm volatile("s_waitcnt vmcnt(0)" ::: "memory");
        } else {
            XB_SPIN(xb_ld(&bar[XB_XGEN(b.x)]) == gen, bar);
            __builtin_amdgcn_fence(__ATOMIC_ACQUIRE, "agent");
            asm volatile("s_waitcnt vmcnt(0)" ::: "memory");
        }
    }
    __syncthreads();
}

constexpr size_t MiB = 1u << 20;
constexpr size_t WS_CTL = 0, CTL_ZERO_BYTES = 1 * MiB;
constexpr size_t WS_HMETA = 1 * MiB;
constexpr size_t WS_ROPE = 2 * MiB;
constexpr size_t WS_ROUTE = 6 * MiB + 256 * 1024;
constexpr size_t WA = 8 * MiB;
constexpr size_t WA_FIN = WA, WA_FOUT = WA + 8 * MiB + 512 * 1024, WA_FFIN = WA_FOUT + 2 * MiB, WA_FFOUT = WA_FFIN + 11 * MiB;
constexpr size_t WB = 36 * MiB;
constexpr size_t WB_MIN = WB, WB_QUP = WB + 1 * MiB, WB_KVUP = WB + 2 * MiB, WB_MOUT = WB + 3 * MiB, WB_MOEIN = WB + 5 * MiB, WB_MOEOUT = WB_MOEIN + 44 * MiB;
constexpr size_t WS_H16 = 107 * MiB;
constexpr size_t WS_XN = 180 * MiB;
constexpr size_t ACT = 245 * MiB;
constexpr size_t F_QK = ACT, F_G = ACT + 129 * MiB, F_VP = ACT + 194 * MiB, F_KP = ACT + 260 * MiB, F_O = ACT + 343 * MiB, F_LF = ACT + 408 * MiB, F_CT = ACT + 411 * MiB, F_TS = ACT + 414 * MiB;
constexpr size_t D_HF = ACT;
constexpr size_t M_CRAW = ACT, M_CQ = ACT + 33 * MiB, M_CKV = ACT + 50 * MiB, M_KR = ACT + 67 * MiB, M_QRAW = ACT + 70 * MiB, M_KN = ACT + 167 * MiB, M_VP = ACT + 232 * MiB, M_KP = ACT + 298 * MiB, M_O = M_KN;
constexpr size_t E_XG = ACT, E_HF = ACT + 133 * MiB, E_Y = E_XG;
constexpr size_t WS_SSP = ACT + 499 * MiB;
constexpr size_t WS_SSPM = WS_HMETA + 65536;
constexpr size_t WS_NEED = ACT + 502 * MiB;
static_assert(WA_FFOUT + (size_t)1024 * 2816 * 2 <= WB && WB_MOEOUT + (size_t)8 * 1024 * 2816 <= WS_H16 && WS_H16 + (size_t)RPAD * 2048 <= WS_XN && WS_XN + (size_t)RPAD * 2048 <= ACT, "weights / xn map");
static_assert(F_QK + (size_t)RPAD * 4096 <= F_G && F_G + (size_t)RPAD * 2048 <= F_VP && F_VP + (size_t)LROWS * 2048 <= F_KP && F_KP + (size_t)LROWS * 2560 <= F_O && F_O + (size_t)RPAD * 2048 <= F_LF && F_LF + (size_t)RPAD * 64 <= F_CT && F_CT + (size_t)RPAD * 64 <= WS_SSP, "fox map");
static_assert(M_CRAW + (size_t)RPAD * 1024 <= M_CQ && M_CQ + (size_t)RPAD * 512 <= M_CKV && M_CKV + (size_t)RPAD * 512 <= M_KR && M_KR + (size_t)RPAD * 64 <= M_QRAW && M_QRAW + (size_t)RPAD * 3072 <= M_KN && M_KN + (size_t)RPAD * 2048 <= M_VP && M_VP + (size_t)LROWS * 2048 <= M_KP && M_KP + (size_t)LROWS * 3072 <= WS_SSP, "mla map");
static_assert(E_XG + (size_t)RG_MAX * 2048 <= E_HF && E_HF + (size_t)RG_MAX * DFF * 2 <= WS_SSP && D_HF + (size_t)RPAD * DFF * 2 <= WS_SSP && WS_SSP + (size_t)RPAD * 64 <= WS_NEED && WS_ROPE + (size_t)LROWS * 128 <= WS_ROUTE && WS_ROUTE + (size_t)RPAD * 32 <= WA, "moe / misc map");
constexpr int CW_BAR = 4096;
constexpr int CW_ATTQ = 12288;
constexpr int CW_CNT = 16384;

constexpr int RING_BYTES = 131072;
constexpr int MISC_OFF = RING_BYTES + 320;
constexpr int PT_OFF = MISC_OFF + 128;
constexpr int LDS_BYTES = 147456;
static_assert(attn_body::LDS_BYTES + 64 <= RING_BYTES, "attention LDS");

#ifndef CFG_F8_FFN0
#define CFG_F8_FFN0 0
#endif
#ifndef CFG_F8_FFN2
#define CFG_F8_FFN2 0
#endif
#ifndef CFG_F8_MOE1
#define CFG_F8_MOE1 1
#endif
#ifndef CFG_F8_MOE3
#define CFG_F8_MOE3 1
#endif
#ifndef TAIL_MASK
#define TAIL_MASK 0x7f
#endif
#define TAIL_ON(bit) ((TAIL_MASK >> (bit)) & 1)
static_assert(CFG_F8_MOE1 && CFG_F8_MOE3, "the workspace map assumes e4m3 expert weights in both MoE layers");
constexpr int NWAVES = 8, NTHREADS = 512;
constexpr int NPH = 19, N_PHASES = 2 * NPH + 1;

struct Args { const float* in[49]; float* out; unsigned char* ws; int ph_lo, ph_hi; };

struct Ctx { LAS unsigned char* lds; int tid, lane, wave, vcu, G, gw, NGW; };

__device__ __forceinline__ void zero_bytes(void* p, size_t nbytes, const Ctx& C) {
    const u32x4 z = {0u, 0u, 0u, 0u};
    for (size_t i = (size_t)(C.vcu * NTHREADS + C.tid); i < nbytes / 16; i += (size_t)C.G * NTHREADS) ((u32x4*)p)[i] = z;
}
__device__ __forceinline__ void tr_load(const float* W, int sp, int k0, int c0, int lane, f32x4 (&v)[8]) {
    const int n4 = (lane & 7) * 4, kr = lane >> 3;
#pragma unroll
    for (int i = 0; i < 8; ++i) v[i] = *(const f32x4*)(W + (size_t)(k0 + kr + 8 * i) * sp + c0 + n4);
}
template <bool F8> __device__ __forceinline__ void tr_fin(const f32x4 (&v)[8], int k0, void* WT, int dp, int drow0, LAS float* scr, int lane, const float* gain = nullptr) {
    { const int n4 = (lane & 7) * 4, kr = lane >> 3;
#pragma unroll
        for (int i = 0; i < 8; ++i) { LAS float* d = scr + (kr + 8 * i) * 33 + n4; d[0] = v[i].x; d[1] = v[i].y; d[2] = v[i].z; d[3] = v[i].w; }
    }
    LDS_WAIT(); asm volatile("" ::: "memory");
    const int c = lane & 7;
    f32x4 gA = {1.f, 1.f, 1.f, 1.f}, gB = gA; if (gain) { gA = *(const f32x4*)(gain + k0 + 8 * c); gB = *(const f32x4*)(gain + k0 + 8 * c + 4); }
#pragma unroll
    for (int j = 0; j < 4; ++j) { const int n = (lane >> 3) + 8 * j; const LAS float* s = scr + (8 * c) * 33 + n;
        if constexpr (F8) { u32x2 o; o.x = pack4_fp8(s[0 * 33] * F8_SW, s[1 * 33] * F8_SW, s[2 * 33] * F8_SW, s[3 * 33] * F8_SW); o.y = pack4_fp8(s[4 * 33] * F8_SW, s[5 * 33] * F8_SW, s[6 * 33] * F8_SW, s[7 * 33] * F8_SW);
            *(u32x2*)((unsigned char*)WT + (size_t)(drow0 + n) * dp + k0 + 8 * c) = o; }
        else { u32x4 o; o.x = cvt_pk_bf16(s[0 * 33] * gA[0], s[1 * 33] * gA[1]); o.y = cvt_pk_bf16(s[2 * 33] * gA[2], s[3 * 33] * gA[3]); o.z = cvt_pk_bf16(s[4 * 33] * gB[0], s[5 * 33] * gB[1]); o.w = cvt_pk_bf16(s[6 * 33] * gB[2], s[7 * 33] * gB[3]);
            *(u32x4*)((bf16_t*)WT + (size_t)(drow0 + n) * dp + k0 + 8 * c) = o; } }
    LDS_WAIT(); asm volatile("" ::: "memory");
}
template <bool F8> __device__ __forceinline__ void tr_item(const float* W, int sp, int k0, int c0, void* WT, int dp, int drow0, LAS float* scr, int lane, const float* gain = nullptr) {
    f32x4 v[8]; tr_load(W, sp, k0, c0, lane, v); tr_fin<F8>(v, k0, WT, dp, drow0, scr, lane, gain);
}
template <int KIND> __device__ __forceinline__ int dst_row(int c) {
    if (KIND == 1) { const int up = c >= DFF, i = up ? c - DFF : c; return (i >> 7) * 256 + up * 128 + (i & 127); }
    if (KIND == 2) { const int h = c >> 7, j = c & 127; return j < 64 ? (h >> 2) * 256 + (j >> 5) * 128 + (h & 3) * 32 + (j & 31) : 1024 + h * 64 + (j - 64); }
    if (KIND == 3) { if (c < 1024 || c >= 2048) return c; const int h = (c - 1024) >> 6, j = c & 63; return 1024 + (h >> 2) * 256 + (j >> 5) * 128 + (h & 3) * 32 + (j & 31); }
    return c;
}
template <int KIND, bool F8 = false> __device__ __forceinline__ void tr_mat_item(const float* W, int ncols, int sp, void* WT, int dp, int it, LAS float* scr, int lane, const float* gain = nullptr) {
    const int nblk = ncols / 32, kb = it / nblk, nb = it % nblk;
    tr_item<F8>(W, sp, 64 * kb, 32 * nb, WT, dp, dst_row<KIND>(32 * nb), scr, lane, gain);
}
__device__ __forceinline__ void tr_mat_load(const float* W, int ncols, int sp, int it, int lane, f32x4 (&v)[8]) { const int nblk = ncols / 32, kb = it / nblk, nb = it % nblk; tr_load(W, sp, 64 * kb, 32 * nb, lane, v); }
template <int KIND, bool F8 = false> __device__ __forceinline__ void tr_mat_fin(const f32x4 (&v)[8], int ncols, void* WT, int dp, int it, LAS float* scr, int lane, const float* gain = nullptr) {
    const int nblk = ncols / 32, kb = it / nblk, nb = it % nblk; tr_fin<F8>(v, 64 * kb, WT, dp, dst_row<KIND>(32 * nb), scr, lane, gain);
}

__device__ __forceinline__ void load_row(const float* src, f32x4 (&v)[4], int lane) {
    const GAS f32x4* p = (const GAS f32x4*)src + lane;
#pragma unroll
    for (int j = 0; j < 4; ++j) v[j] = p[64 * j];
}
__device__ __forceinline__ void store_row(float* dst, const f32x4 (&v)[4], int lane) {
    GAS f32x4* p = (GAS f32x4*)dst + lane;
#pragma unroll
    for (int j = 0; j < 4; ++j) p[64 * j] = v[j];
}
__device__ __forceinline__ void load_row16(const bf16_t* src, f32x4 (&v)[4], int lane) {
    const GAS u32x2* p = (const GAS u32x2*)src + lane;
#pragma unroll
    for (int j = 0; j < 4; ++j) { const u32x2 w = p[64 * j]; v[j] = (f32x4){bf_lo(w.x), bf_hi(w.x), bf_lo(w.y), bf_hi(w.y)}; }
}
__device__ __forceinline__ void store_row16(bf16_t* dst, const f32x4 (&v)[4], int lane) {
    GAS u32x2* p = (GAS u32x2*)dst + lane;
#pragma unroll
    for (int j = 0; j < 4; ++j) { u32x2 w; w.x = cvt_pk_bf16(v[j].x, v[j].y); w.y = cvt_pk_bf16(v[j].z, v[j].w); p[64 * j] = w; }
}
__device__ __forceinline__ void load_gain(const float* g, f32x4 (&gv)[4], int lane) {
#pragma unroll
    for (int j = 0; j < 4; ++j) gv[j] = *(const f32x4*)(g + 4 * lane + 256 * j);
}
template <bool F8 = false> __device__ __forceinline__ void norm_row(f32x4 (&v)[4], const f32x4 (&gv)[4], void* dst, int lane) {
    float s = 0.f;
#pragma unroll
    for (int j = 0; j < 4; ++j) s += (v[j].x * v[j].x + v[j].y * v[j].y) + (v[j].z * v[j].z + v[j].w * v[j].w);
    const float rn = __builtin_amdgcn_rsqf(wave_sum(s) * (1.0f / 1024.0f) + EPSN);
#pragma unroll
    for (int j = 0; j < 4; ++j) { v[j] = v[j] * rn * gv[j];
        if constexpr (F8) ((GAS unsigned*)dst)[lane + 64 * j] = pack4_fp8(v[j].x * F8_SX, v[j].y * F8_SX, v[j].z * F8_SX, v[j].w * F8_SX);
        else { u32x2 w; w.x = cvt_pk_bf16(v[j].x, v[j].y); w.y = cvt_pk_bf16(v[j].z, v[j].w); ((GAS u32x2*)dst)[lane + 64 * j] = w; } }
}
__device__ __forceinline__ void moe_combine_row(f32x4 (&v)[4], const u32x4 ra, const u32x2 rb, const int* roff, const bf16_t* Y, int lane) {
    int r0 = 0, r1 = 0;
#pragma unroll
    for (int e = 0; e < 8; ++e) { r0 = (int)ra.x == e ? roff[e] : r0; r1 = (int)ra.y == e ? roff[e] : r1; }
    r0 += (int)ra.z; r1 += (int)ra.w; const float w0 = __uint_as_float(rb.x), w1 = __uint_as_float(rb.y);
    const GAS u32x2* y0 = (const GAS u32x2*)(Y + (size_t)r0 * 1024) + lane; const GAS u32x2* y1 = (const GAS u32x2*)(Y + (size_t)r1 * 1024) + lane;
#pragma unroll
    for (int j = 0; j < 4; ++j) { const u32x2 a = y0[64 * j], b = y1[64 * j];
        v[j].x += w0 * bf_lo(a.x) + w1 * bf_lo(b.x); v[j].y += w0 * bf_hi(a.x) + w1 * bf_hi(b.x); v[j].z += w0 * bf_lo(a.y) + w1 * bf_lo(b.y); v[j].w += w0 * bf_hi(a.y) + w1 * bf_hi(b.y); }
}
__device__ __forceinline__ int moe_offsets(const gu32* cnt, int (&toff)[9]) {
    int t = 0;
#pragma unroll
    for (int e = 0; e < 8; ++e) { toff[e] = t; const unsigned c = __hip_atomic_load(cnt + 64 * e, RLX_AGENT); t += (int)((c + 255u) >> 8); }
    toff[8] = t; return t;
}

template <int MODE> __device__ __forceinline__ void kprep_row(const u32x4 a, const u32x4 b, const u32x4 krt, const f32x4 (&g)[4], bf16_t* KPb, int lrow0, int nd, float cval, int lane) {
    constexpr int DKP = MODE == 0 ? 80 : 96, KPITCH = 16 * DKP;
    const int h = lane >> 2, q4 = lane & 3;
    float x[16];
#pragma unroll
    for (int j = 0; j < 4; ++j) { x[2 * j] = bf_lo(a[j]); x[2 * j + 1] = bf_hi(a[j]); x[8 + 2 * j] = bf_lo(b[j]); x[8 + 2 * j + 1] = bf_hi(b[j]); }
    float ss = 0.f;
#pragma unroll
    for (int j = 0; j < 16; ++j) ss += x[j] * x[j];
    ss += __shfl_xor(ss, 1); ss += __shfl_xor(ss, 2);
    const float rn = 1.0f / sqrtf(ss * (1.0f / 64.0f) + EPSN);
    u32x4 o0, o1;
#pragma unroll
    for (int j = 0; j < 4; ++j) { const int i0 = 2 * j, i1 = 8 + 2 * j;
        o0[j] = cvt_pk_bf16(x[i0] * rn * g[i0 >> 2][i0 & 3], x[i0 + 1] * rn * g[(i0 + 1) >> 2][(i0 + 1) & 3]);
        o1[j] = cvt_pk_bf16(x[i1] * rn * g[i1 >> 2][i1 & 3], x[i1 + 1] * rn * g[(i1 + 1) >> 2][(i1 + 1) & 3]); }
    u32x4 tl = {0u, 0u, 0u, 0u}; bool has_tail;
    if (MODE == 0) {
        has_tail = q4 < 2;
        if (q4 == 0) { const float ng = -cval * LOG2E; const bf16_t h1 = f2bf(ng); const float f1 = bf2f(h1); const bf16_t h2 = f2bf(ng - f1); const float f2 = bf2f(h2); const bf16_t h3 = f2bf(ng - f1 - f2);
            tl.x = (unsigned)h1 | ((unsigned)h2 << 16); tl.y = (unsigned)h3 | 0x3F800000u; tl.z = 0x3F803F80u; tl.w = 0u; }
    } else { has_tail = true; tl = krt; }
    for (int d = 0; d < nd; ++d) { bf16_t* base = KPb + (size_t)(lrow0 + d * LP) * KPITCH + h * DKP;
        *(u32x4*)(base + 16 * q4) = o0; *(u32x4*)(base + 16 * q4 + 8) = o1;
        if (has_tail) *(u32x4*)(base + 64 + 8 * q4) = tl; }
}

__device__ __forceinline__ f32x4 tail_tile(const bf16_t* A16, int lda, const bf16_t* B16, int ldb, int K, int lane) {
    const int fr = lane & 15, fq = lane >> 4;
    const bf16_t* ap = A16 + (size_t)fr * lda + 8 * fq; const bf16_t* bp = B16 + (size_t)fr * ldb + 8 * fq;
    f32x4 acc = {0.f, 0.f, 0.f, 0.f};
    for (int k = 0; k < K; k += 256) { bf16x8 a[8], b[8];
#pragma unroll
        for (int i = 0; i < 8; ++i) { a[i] = *(const bf16x8*)(ap + k + 32 * i); b[i] = *(const bf16x8*)(bp + k + 32 * i); }
#pragma unroll
        for (int i = 0; i < 8; ++i) acc = __builtin_amdgcn_mfma_f32_16x16x32_bf16(b[i], a[i], acc, 0, 0, 0); }
    return acc;
}
template <int DKP> __device__ __forceinline__ void tail_khead(const bf16_t* A16, int lda, const bf16_t* Bhead, int K, const float* gk, bf16_t* Kp, int head, int lane) {
    const int fr = lane & 15, fq = lane >> 4; f32x4 v[4] = {}; float ss = 0.f;
    {
        const bf16_t* ap = A16 + (size_t)fr * lda + 8 * fq; const bf16_t* bp = Bhead + (size_t)fr * K + 8 * fq;
        for (int k = 0; k < K; k += 256) { bf16x8 a[8], b[4][8];
#pragma unroll
            for (int i = 0; i < 8; ++i) a[i] = *(const bf16x8*)(ap + k + 32 * i);
#pragma unroll
            for (int ti = 0; ti < 4; ++ti)
#pragma unroll
                for (int i = 0; i < 8; ++i) b[ti][i] = *(const bf16x8*)(bp + (size_t)((ti >> 1) * 128 + (ti & 1) * 16) * K + k + 32 * i);
#pragma unroll
            for (int ti = 0; ti < 4; ++ti)
#pragma unroll
                for (int i = 0; i < 8; ++i) v[ti] = __builtin_amdgcn_mfma_f32_16x16x32_bf16(b[ti][i], a[i], v[ti], 0, 0, 0); }
    }
#pragma unroll
    for (int ti = 0; ti < 4; ++ti) ss += (v[ti][0] * v[ti][0] + v[ti][1] * v[ti][1]) + (v[ti][2] * v[ti][2] + v[ti][3] * v[ti][3]);
    ss += __shfl_xor(ss, 16); ss += __shfl_xor(ss, 32);
    const float rn = __builtin_amdgcn_rsqf(ss * (1.0f / 64.0f) + EPSN);
#pragma unroll
    for (int ti = 0; ti < 4; ++ti) { const f32x4 g = *(const f32x4*)(gk + 16 * ti + 4 * fq); const f32x4 o = v[ti] * rn * g; u32x2 w; w.x = attn_body::cvtpk_s(o[0], o[1]); w.y = attn_body::cvtpk_s(o[2], o[3]);
        for (int b = 0; b < NB; ++b) *(u32x2*)(Kp + (size_t)(b * LP + fr) * (16 * DKP) + head * DKP + 16 * ti + 4 * fq) = w; }
}
__device__ __forceinline__ u32x2 pack4_bf16(const f32x4 v) { u32x2 w; w.x = attn_body::cvtpk_s(v[0], v[1]); w.y = attn_body::cvtpk_s(v[2], v[3]); return w; }
__device__ __forceinline__ const void* ldptr(LAS unsigned char* pt, int k) {
    const LAS unsigned* p = (const LAS unsigned*)pt + 2 * k; const unsigned lo = p[0], hi = p[1];
    return (const void*)(const GAS void*)(((unsigned long long)(unsigned)__builtin_amdgcn_readfirstlane((int)hi) << 32) | (unsigned)__builtin_amdgcn_readfirstlane((int)lo));
}
__global__ void __launch_bounds__(NTHREADS, 2) trunk_fwd(Args args) {
    extern __shared__ __attribute__((aligned(16))) unsigned char lds_raw[];
#define MAKE_CTX(C) Ctx C; { int t_ = threadIdx.x; asm volatile("" : "+v"(t_)); C.lds = (LAS unsigned char*)lds_raw; C.tid = t_; C.lane = t_ & 63; C.wave = __builtin_amdgcn_readfirstlane(t_ >> 6); \
        C.G = gridDim.x; { const int bx = blockIdx.x; C.vcu = (C.G % 8 == 0) ? (bx % 8) * (C.G / 8) + bx / 8 : bx; } C.gw = C.vcu * NWAVES + C.wave; C.NGW = C.G * NWAVES; }
    MAKE_CTX(C0);
    volatile LAS unsigned* MISC = (volatile LAS unsigned*)(C0.lds + MISC_OFF);
    for (int u = C0.tid; u < (LDS_BYTES - RING_BYTES) / 4; u += NTHREADS) ((LAS unsigned*)(C0.lds + RING_BYTES))[u] = 0u;
    __syncthreads();
    if (C0.tid < 51) { const unsigned long long v = C0.tid < 49 ? (unsigned long long)args.in[C0.tid] : (C0.tid == 49 ? (unsigned long long)args.out : (unsigned long long)args.ws); ((LAS unsigned long long*)(C0.lds + PT_OFF))[C0.tid] = v; }
    __syncthreads();
    unsigned char* ws0 = (unsigned char*)ldptr(C0.lds + PT_OFF, 50);
    gu32* ctl0 = (gu32*)(ws0 + WS_CTL);
#define PHASE_LOCALS MAKE_CTX(C); const int tw = C.wave * C.G + C.vcu, fr_ = C.lane & 15, fq_ = C.lane >> 4; (void)tw; (void)fr_; (void)fq_; LAS float* scr = (LAS float*)(C.lds + C.wave * 16384); (void)scr; unsigned long long wsi_ = (unsigned long long)ldptr(C.lds + PT_OFF, 50); asm volatile("" : "+s"(wsi_)); unsigned char* ws = (unsigned char*)(GAS unsigned char*)wsi_; gu32* ctl = (gu32*)(ws + WS_CTL); float* hreal = (float*)ldptr(C.lds + PT_OFF, 49); float* hmeta = (float*)(ws + WS_HMETA); float* rope = (float*)(ws + WS_ROPE); unsigned* route = (unsigned*)(ws + WS_ROUTE); bf16_t* XN = (bf16_t*)(ws + WS_XN); bf16_t* H16 = (bf16_t*)(ws + WS_H16); (void)H16; const gu32* cnt_prev = ctl + CW_CNT + (lp > 0 ? (lp - 1) * 1024 : 0); gu32* cnt = ctl + CW_CNT + lp * 1024; (void)hreal; (void)hmeta; (void)rope; (void)route; (void)XN; (void)cnt_prev; (void)cnt;
    XcdBarrier bar = xcd_barrier_post((unsigned*)(ctl0 + CW_BAR), MISC + 8);
    const int lo = args.ph_lo, hi = args.ph_hi;
#define IN(k) (lo <= (k) && (k) < hi)
#define SEAM(k) do { if (IN(k) && IN((k) + 1)) xcd_barrier(bar); } while (0)
#ifdef ONLY_PHASE
#define PHEN(c) ((c) == ONLY_PHASE)
#else
#define PHEN(c) true
#endif
#define INP(c) (PHEN(c) && IN(P0 + (c)))
#define SEAMP(c) SEAM(P0 + (c))

#define X_IN ((const float*)ldptr(C.lds + PT_OFF, 0))
#define POS_IN ((const int*)ldptr(C.lds + PT_OFF, 1))
#define META_IN ((const float*)ldptr(C.lds + PT_OFF, 2))
#define WP(k) ((const float*)ldptr(C.lds + PT_OFF, 3 + lp * 23 + (k)))
#define LOAD_H(m, v) do { if ((m) < NREAL) load_row16(H16 + (size_t)(m) * 1024, v, C.lane); else load_row(hmeta + (size_t)((m) - NREAL) * 1024, v, C.lane); } while (0)
#define STORE_H(m, v) do { if ((m) < NREAL) store_row16(H16 + (size_t)(m) * 1024, v, C.lane); else store_row(hmeta + (size_t)((m) - NREAL) * 1024, v, C.lane); } while (0)

    for (int lp = 0; lp < 2; ++lp) {
        const int P0 = lp * NPH;
        const bool f8ffn = lp ? (bool)CFG_F8_FFN2 : (bool)CFG_F8_FFN0, f8moe = lp ? (bool)CFG_F8_MOE3 : (bool)CFG_F8_MOE1;


        if (INP(0)) { PHASE_LOCALS
            if (lp == 0) {
                const int* positions = POS_IN;
                for (int i = C.vcu * NTHREADS + C.tid; i < LROWS * 16; i += C.G * NTHREADS) { const int lr = i >> 4, f = i & 15, b = lr / LP, pos = lr % LP;
                    const int p = pos < NMETA ? pos : (pos < LVALID ? positions[b * SEQ + pos - NMETA] : 0);
                    const float ang = (float)p * powf(10000.0f, -(float)(2 * f) / 32.0f);
                    rope[(size_t)lr * 32 + f] = cosf(ang); rope[(size_t)lr * 32 + 16 + f] = sinf(ang); }
                zero_bytes(XN + (size_t)NROWS * 1024, (size_t)(RPAD - NROWS) * 2048, C);
            }
            zero_bytes(ws + WA_FIN + (size_t)4112 * 2048, (size_t)240 * 2048, C);
            for (int b = 0; b < NB; ++b) { zero_bytes(ws + F_VP + (size_t)(b * LP + LVALID) * 2048, (size_t)(LP - LVALID) * 2048, C); zero_bytes(ws + F_KP + (size_t)(b * LP + LVALID) * 2560, (size_t)(LP - LVALID) * 2560, C); }
            {
                constexpr int I1 = 16 * 128, I2 = 16 * 32, I3 = 16 * 176, I4 = 44 * 32, I5 = 16, NIT = I1 + I2 + I3 + I4 + I5;
                for (int it = C.gw; it < NIT; it += C.NGW) { int r = it;
                    if (r < I1) { tr_mat_item<3>(WP(1), 4096, 4112, (bf16_t*)(ws + WA_FIN), 1024, r, scr, C.lane); continue; } r -= I1;
                    if (r < I2) { tr_mat_item<0>(WP(5), 1024, 1024, (bf16_t*)(ws + WA_FOUT), 1024, r, scr, C.lane); continue; } r -= I2;
                    if (r < I3) { tr_mat_item<1>(WP(7), 5632, 5632, ws + WA_FFIN, 1024, r, scr, C.lane, WP(6)); continue; } r -= I3;
                    if (r < I4) { if (f8ffn) tr_mat_item<0, true>(WP(8), 1024, 1024, ws + WA_FFOUT, 2816, r, scr, C.lane); else tr_mat_item<0>(WP(8), 1024, 1024, ws + WA_FFOUT, 2816, r, scr, C.lane); continue; } r -= I4;
                    { const int k = r * 64 + C.lane; const float* s = WP(1) + (size_t)k * 4112 + 4096; bf16_t* d = (bf16_t*)(ws + WA_FIN) + (size_t)4096 * 1024 + k;
#pragma unroll
                      for (int j = 0; j < 16; ++j) d[(size_t)j * 1024] = f2bf(s[j]); }
                }
            }
            zero_bytes(ws + WB_MIN + (size_t)416 * 2048, (size_t)96 * 2048, C);
            for (int i = C.vcu * NTHREADS + C.tid; i < 2048 * 16; i += C.G * NTHREADS) *(u32x4*)((bf16_t*)(ws + WB_KVUP) + (size_t)(i >> 4) * 256 + 128 + (i & 15) * 8) = (u32x4){0u, 0u, 0u, 0u};
            {
                constexpr int J1 = 16 * 13, J2 = 4 * 48, J3 = 2 * 64, J4 = 16 * 32, J5 = 8 * 2816, J6 = 8 * 1408, NIT = J1 + J2 + J3 + J4 + J5 + J6;
#define JSRC(itx, vx) do { int r_ = (itx); \
                    if (r_ < J1) tr_mat_load(WP(10), 416, 416, r_, C.lane, vx); else { r_ -= J1; \
                    if (r_ < J2) tr_mat_load(WP(12), 1536, 1536, r_, C.lane, vx); else { r_ -= J2; \
                    if (r_ < J3) tr_mat_load(WP(14), 2048, 2048, r_, C.lane, vx); else { r_ -= J3; \
                    if (r_ < J4) tr_mat_load(WP(18), 1024, 1024, r_, C.lane, vx); else { r_ -= J4; \
                    if (r_ < J5) tr_mat_load(WP(21) + (size_t)(r_ / 2816) * 1024 * 5632, 5632, 5632, r_ % 2816, C.lane, vx); else { r_ -= J5; \
                    tr_mat_load(WP(22) + (size_t)(r_ / 1408) * DFF * 1024, 1024, 1024, r_ % 1408, C.lane, vx); } } } } } } while (0)
                f32x4 v[8] = {}; if (C.gw < NIT) JSRC(C.gw, v);
                for (int it = C.gw; it < NIT; it += C.NGW) { int r = it; f32x4 nv[8] = {v[0], v[1], v[2], v[3], v[4], v[5], v[6], v[7]};
                    if (it + C.NGW < NIT) JSRC(it + C.NGW, nv);
                    if (r < J1) tr_mat_fin<0>(v, 416, (bf16_t*)(ws + WB_MIN), 1024, r, scr, C.lane, WP(9));
                    else { r -= J1;
                    if (r < J2) tr_mat_fin<0>(v, 1536, (bf16_t*)(ws + WB_QUP), 256, r, scr, C.lane);
                    else { r -= J2;
                    if (r < J3) tr_mat_fin<2>(v, 2048, (bf16_t*)(ws + WB_KVUP), 256, r, scr, C.lane);
                    else { r -= J3;
                    if (r < J4) tr_mat_fin<0>(v, 1024, (bf16_t*)(ws + WB_MOUT), 1024, r, scr, C.lane);
                    else { r -= J4;
                    if (r < J5) { const int e = r / 2816; if (f8moe) tr_mat_fin<1, true>(v, 5632, ws + WB_MOEIN + (size_t)e * 5632 * 1024, 1024, r % 2816, scr, C.lane); else tr_mat_fin<1>(v, 5632, ws + WB_MOEIN + (size_t)e * 5632 * 1024 * 2, 1024, r % 2816, scr, C.lane); }
                    else { r -= J5; const int e = r / 1408; if (f8moe) tr_mat_fin<0, true>(v, 1024, ws + WB_MOEOUT + (size_t)e * 1024 * DFF, DFF, r % 1408, scr, C.lane); else tr_mat_fin<0>(v, 1024, ws + WB_MOEOUT + (size_t)e * 1024 * DFF * 2, DFF, r % 1408, scr, C.lane); } } } } }
#pragma unroll
                    for (int i = 0; i < 8; ++i) v[i] = nv[i];
                }
#undef JSRC
            }
            {
                f32x4 gv[4]; load_gain(WP(0), gv, C.lane); const float* xin = X_IN; const float* metain = META_IN;
                int roff[9] = {0, 0, 0, 0, 0, 0, 0, 0, 0}; if (lp > 0) moe_offsets(cnt_prev, roff);
#pragma unroll
                for (int e = 0; e < 9; ++e) roff[e] *= 256;
#define ROW0_LOAD(m, v) do { if (lp == 0) load_row((m) < NREAL ? xin + (size_t)(m) * 1024 : metain + (size_t)((m) - NREAL) * 1024, v, C.lane); else LOAD_H(m, v); } while (0)
                f32x4 v[4] = {}; u32x4 ra = {0u, 0u, 0u, 0u}; u32x2 rb = {0u, 0u}; int m = C.gw;
                if (m < NROWS) { ROW0_LOAD(m, v); if (lp > 0) { ra = *(const u32x4*)(route + (size_t)m * 8); rb = *(const u32x2*)(route + (size_t)m * 8 + 4); } }
                for (; m < NROWS; m += C.NGW) { const int mn = m + C.NGW; f32x4 nv[4] = {v[0], v[1], v[2], v[3]}; u32x4 nra = {0u, 0u, 0u, 0u}; u32x2 nrb = {0u, 0u};
                    if (mn < NROWS) { ROW0_LOAD(mn, nv); if (lp > 0) { nra = *(const u32x4*)(route + (size_t)mn * 8); nrb = *(const u32x2*)(route + (size_t)mn * 8 + 4); } }
                    if (lp > 0) { moe_combine_row(v, ra, rb, roff, (const bf16_t*)(ws + E_Y), C.lane); STORE_H(m, v); } else if (m < NREAL) store_row16(H16 + (size_t)m * 1024, v, C.lane);
                    norm_row(v, gv, XN + (size_t)m * 1024, C.lane);
#pragma unroll
                    for (int j = 0; j < 4; ++j) v[j] = nv[j];
                    ra = nra; rb = nrb; }
#undef ROW0_LOAD
            }
        }
        SEAMP(0);
        if (INP(1)) { PHASE_LOCALS
            if (TAIL_ON(0)) {
                const bf16_t* A16 = XN + (size_t)NREAL * 1024; const bf16_t* Bt = (const bf16_t*)(ws + WA_FIN); bf16_t* QK = (bf16_t*)(ws + F_QK); bf16_t* Vp = (bf16_t*)(ws + F_VP); bf16_t* Gt = (bf16_t*)(ws + F_G); float* lf = (float*)(ws + F_LF); float* tsum = (float*)(ws + F_TS);
                for (int tt = ((C.wave + 7) & 7) * C.G + C.vcu; tt < 208; tt += C.NGW) {
                    if (tt >= 64 && tt < 80) { const int hh = tt - 64; tail_khead<80>(A16, 1024, Bt + (size_t)(1024 + (hh >> 2) * 256 + (hh & 3) * 32) * 1024, 1024, WP(4), (bf16_t*)(ws + F_KP), hh, C.lane); continue; }
                    const int t = tt < 64 ? tt : tt + 48;
                    const u32x2 w = pack4_bf16(tail_tile(A16, 1024, Bt + (size_t)16 * t * 1024, 1024, 1024, C.lane)); const int col = 16 * t + 4 * fq_;
                    if (t < 64) *(u32x2*)(QK + (size_t)(NREAL + fr_) * 2048 + col) = w;
                    else if (t < 192) { for (int b = 0; b < NB; ++b) *(u32x2*)(Vp + (size_t)(b * LP + fr_) * 1024 + col - 2048) = w; }
                    else *(u32x2*)(Gt + (size_t)(NREAL + fr_) * 1024 + col - 3072) = w; }
                const f32x4 bv = *(const f32x4*)(WP(2) + 4 * fq_);
                for (int t = tw; t < NROWS / 16; t += C.NGW) { const f32x4 z = tail_tile(XN + (size_t)16 * t * 1024, 1024, Bt + (size_t)4096 * 1024, 1024, 1024, C.lane) + bv; f32x4 o;
#pragma unroll
                    for (int j = 0; j < 4; ++j) o[j] = fminf(z[j], 0.f) - log1pf(expf(-fabsf(z[j])));
                    *(f32x4*)(lf + (size_t)(16 * t + fr_) * 16 + 4 * fq_) = o;
#pragma unroll
                    for (int j = 0; j < 4; ++j) { float s = o[j]; s += __shfl_xor(s, 1); s += __shfl_xor(s, 2); s += __shfl_xor(s, 4); s += __shfl_xor(s, 8); o[j] = s; }
                    if (fr_ == 0) *(f32x4*)(tsum + (size_t)t * 16 + 4 * fq_) = o; }
            }
            constexpr int MR = TAIL_ON(0) ? NREAL : RPAD, NC = TAIL_ON(0) ? 4096 : 4352;
            pg8::Gemm g{XN, (const bf16_t*)(ws + WA_FIN), MR, NC, 1024}; pg8::StaticOrder S; S.init(MR, NC, C.G, (int)blockIdx.x);
            pg8::EpiFoxIn E{(bf16_t*)(ws + F_QK), (bf16_t*)(ws + F_VP), (bf16_t*)(ws + F_G), (float*)(ws + F_LF), WP(2), (bf16_t*)(ws + F_KP), WP(4)};
            pg8::gemm_phase<pg8::EpiFoxIn, pg8::StaticOrder, true, true>(C.lds, g, S, E);
        }
        SEAMP(1);
        if (INP(2)) { PHASE_LOCALS
            const float* lf = (const float*)(ws + F_LF); const float* tsum = (const float*)(ws + F_TS); float* ctab = (float*)(ws + F_CT); const bf16_t* QK = (const bf16_t*)(ws + F_QK); bf16_t* KPb = (bf16_t*)(ws + F_KP);
            LAS float* red = (LAS float*)C.lds; LAS float* pre = red + 512; LAS float* cs = pre + 16; LAS float* seg = cs + 2048;
            const int hh = C.tid & 15, sg = C.tid >> 4;
            for (int ci = C.vcu; ci < 257; ci += C.G) {
                const bool meta = ci == 256; const int nr = meta ? NMETA : 128, r0 = meta ? NREAL : ci * 128, b = ci >> 6, t0 = (ci & 63) * 128;
                float acc = 0.f;
                if (!meta) { const float* base = tsum + (size_t)b * (SEQ / 16) * 16; for (int t = sg; t < t0 / 16; t += 32) acc += base[(size_t)t * 16 + hh];
                    if (sg == 0) acc += tsum[(size_t)(NREAL / 16) * 16 + hh]; }
                red[sg * 16 + hh] = acc;
                for (int idx = C.tid; idx < nr * 16; idx += NTHREADS) cs[idx] = lf[(size_t)r0 * 16 + idx];
                __syncthreads();
                if (C.tid < 16) { float s = 0.f; for (int k = 0; k < 32; ++k) s += red[k * 16 + C.tid]; pre[C.tid] = s; }
                { float s = 0.f; for (int q = 0; q < 4; ++q) { const int row = sg * 4 + q; if (row < nr) s += cs[row * 16 + hh]; } seg[sg * 16 + hh] = s; }
                __syncthreads();
                float cv[4]; { float p = pre[hh]; for (int k = 0; k < sg; ++k) p += seg[k * 16 + hh]; for (int q = 0; q < 4; ++q) { const int row = sg * 4 + q; if (row < nr) p += cs[row * 16 + hh]; cv[q] = p; } }
                __syncthreads();
                for (int q = 0; q < 4; ++q) { const int row = sg * 4 + q; if (row < nr) { cs[row * 16 + hh] = cv[q]; ctab[(size_t)(r0 + row) * 16 + hh] = cv[q]; } }
                __syncthreads();
                const int rpw = nr / 8;
                for (int rr = 0; rr < rpw; ++rr) { const int row = C.wave * rpw + rr, r = r0 + row;
                    if (C.lane < 32) { const int hd = C.lane >> 1; u32x4 tl = {0u, 0u, 0u, 0u};
                        if ((C.lane & 1) == 0) { const float ng = -cs[row * 16 + hd] * LOG2E; const bf16_t h1 = f2bf(ng); const float f1 = bf2f(h1); const bf16_t h2 = f2bf(ng - f1); const float f2 = bf2f(h2); const bf16_t h3 = f2bf(ng - f1 - f2);
                            tl.x = (unsigned)h1 | ((unsigned)h2 << 16); tl.y = (unsigned)h3 | 0x3F800000u; tl.z = 0x3F803F80u; }
                        const int lrow0 = meta ? row : row_to_lrow(r), nd = meta ? NB : 1;
                        for (int d = 0; d < nd; ++d) *(u32x4*)(KPb + (size_t)(lrow0 + d * LP) * 1280 + hd * 80 + 64 + 8 * (C.lane & 1)) = tl; } }
                __syncthreads();
            }
        }
        SEAMP(2);
        if (INP(3)) { PHASE_LOCALS
            const attn_body::AttnArgs AT{(const bf16_t*)(ws + F_QK), (const bf16_t*)(ws + F_KP), (const bf16_t*)(ws + F_VP), (bf16_t*)(ws + F_O), (const bf16_t*)(ws + F_G), WP(3), (const float*)(ws + F_CT), nullptr};
            if (attn_body::attn_fixref_ok<0>(WP(3), WP(4), nullptr, C.lane)) attn_body::attn_phase<5, 0, 8, true>((char*)lds_raw, AT, (unsigned*)(ctl + CW_ATTQ + (2 * lp) * 64));
            else attn_body::attn_phase<5, 0, 8, false>((char*)lds_raw, AT, (unsigned*)(ctl + CW_ATTQ + (2 * lp) * 64));
        }
        SEAMP(3);
        if (INP(4)) { PHASE_LOCALS
            if (TAIL_ON(1)) { const float* mi = lp == 0 ? META_IN : hmeta;
              for (int t = tw; t < 64; t += C.NGW) { const f32x4 a = tail_tile((const bf16_t*)(ws + F_O) + (size_t)NREAL * 1024, 1024, (const bf16_t*)(ws + WA_FOUT) + (size_t)16 * t * 1024, 1024, 1024, C.lane);
                  const size_t off = (size_t)fr_ * 1024 + 16 * t + 4 * fq_; const f32x4 o = *(const f32x4*)(mi + off) + a; *(f32x4*)(hmeta + off) = o;
                  *(u32x2*)(H16 + (size_t)NREAL * 1024 + off) = pack4_bf16(o); float ss = (o[0] * o[0] + o[1] * o[1]) + (o[2] * o[2] + o[3] * o[3]); ss += __shfl_xor(ss, 16); ss += __shfl_xor(ss, 32);
                  if (fq_ == 0) ((float*)(ws + WS_SSPM))[fr_ * 64 + t] = ss; } }
            constexpr int MR = TAIL_ON(1) ? NREAL : RPAD; pg8::Gemm g{(const bf16_t*)(ws + F_O), (const bf16_t*)(ws + WA_FOUT), MR, 1024, 1024}; pg8::StaticOrder S; S.init(MR, 1024, C.G, (int)blockIdx.x);
            pg8::EpiResidT<true> E{H16, H16, (float*)(ws + WS_SSP), 1.0f, 0};
            pg8::gemm_phase<pg8::EpiResidT<true>, pg8::StaticOrder, true, true>(C.lds, g, S, E);
        }
        SEAMP(4);
        if (INP(6)) { PHASE_LOCALS
            static_assert(!CFG_F8_FFN0 && !CFG_F8_FFN2, "the meta-row tail of the dense FFN is bf16 only");
            if (TAIL_ON(2)) for (int t = tw; t < 176; t += C.NGW) { const int pn = t >> 3, s = t & 7; const bf16_t* A16 = H16 + (size_t)NREAL * 1024; const bf16_t* Bt = (const bf16_t*)(ws + WA_FFIN) + (size_t)(pn * 256 + 16 * s) * 1024;
                f32x4 g4 = tail_tile(A16, 1024, Bt, 1024, 1024, C.lane), u4 = tail_tile(A16, 1024, Bt + (size_t)128 * 1024, 1024, 1024, C.lane); f32x4 o;
                { const float* sp = (const float*)(ws + WS_SSPM) + fr_ * 64; float s = 0.f;
#pragma unroll
                  for (int q = 0; q < 16; ++q) { const f32x4 x = *(const f32x4*)(sp + 4 * q); s += (x[0] + x[1]) + (x[2] + x[3]); }
                  const float rs = 1.0f / sqrtf(s * (1.0f / 1024.0f) + EPSN); g4 = g4 * rs; u4 = u4 * rs; }
#pragma unroll
                for (int j = 0; j < 4; ++j) o[j] = g4[j] * fast_sigmoid(g4[j]) * u4[j];
                *(u32x2*)((bf16_t*)(ws + D_HF) + (size_t)(NREAL + fr_) * DFF + pn * 128 + 16 * s + 4 * fq_) = pack4_bf16(o); }
            constexpr int MR = TAIL_ON(2) ? NREAL : RPAD; pg8::StaticOrder S; S.init(MR, 5632, C.G, (int)blockIdx.x);
            if (f8ffn) { pg8::Gemm g{XN, (const bf16_t*)(ws + WA_FFIN), NREAL, 5632, 512}; pg8::EpiSwiglu<true> E{ws + D_HF, nullptr, 1.0f / (F8_SX * F8_SW), 0};
                pg8::gemm_phase<pg8::EpiSwiglu<true>, pg8::StaticOrder, true, true, true>(C.lds, g, S, E); }
            else { pg8::Gemm g{H16, (const bf16_t*)(ws + WA_FFIN), NREAL, 5632, 1024}; pg8::EpiSwiglu<false> E{ws + D_HF, (const float*)(ws + WS_SSP), 1.0f, 0};
                pg8::gemm_phase<pg8::EpiSwiglu<false>, pg8::StaticOrder, true, true, false>(C.lds, g, S, E); }
        }
        SEAMP(6);
        if (INP(7)) { PHASE_LOCALS
            if (TAIL_ON(3)) for (int t = tw; t < 64; t += C.NGW) { const f32x4 a = tail_tile((const bf16_t*)(ws + D_HF) + (size_t)NREAL * DFF, DFF, (const bf16_t*)(ws + WA_FFOUT) + (size_t)16 * t * DFF, DFF, DFF, C.lane);
                const size_t off = (size_t)fr_ * 1024 + 16 * t + 4 * fq_; const f32x4 o = *(const f32x4*)(hmeta + off) + a; *(f32x4*)(hmeta + off) = o; *(u32x2*)(H16 + (size_t)NREAL * 1024 + off) = pack4_bf16(o); }
            constexpr int MR = TAIL_ON(3) ? NREAL : RPAD; pg8::StaticOrder S; S.init(MR, 1024, C.G, (int)blockIdx.x);
            if (f8ffn) { pg8::Gemm g{(const bf16_t*)(ws + D_HF), (const bf16_t*)(ws + WA_FFOUT), NREAL, 1024, DFF / 2}; pg8::EpiResidT<false> E{H16, H16, nullptr, 1.0f / (F8_SH * F8_SW), 0};
                pg8::gemm_phase<pg8::EpiResidT<false>, pg8::StaticOrder, true, true, true>(C.lds, g, S, E); }
            else { pg8::Gemm g{(const bf16_t*)(ws + D_HF), (const bf16_t*)(ws + WA_FFOUT), NREAL, 1024, DFF}; pg8::EpiResidT<false> E{H16, H16, nullptr, 1.0f, 0};
                pg8::gemm_phase<pg8::EpiResidT<false>, pg8::StaticOrder, true, true, false>(C.lds, g, S, E); }
        }
        SEAMP(7);
        if (INP(9)) { PHASE_LOCALS
            for (int b = 0; b < NB; ++b) { zero_bytes(ws + M_VP + (size_t)(b * LP + LVALID) * 2048, (size_t)(LP - LVALID) * 2048, C); zero_bytes(ws + M_KP + (size_t)(b * LP + LVALID) * 3072, (size_t)(LP - LVALID) * 3072, C); }
            if (TAIL_ON(4)) for (int t = tw; t < 32; t += C.NGW) *(u32x2*)((bf16_t*)(ws + M_CRAW) + (size_t)(NREAL + fr_) * 512 + 16 * t + 4 * fq_) = pack4_bf16(tail_tile(H16 + (size_t)NREAL * 1024, 1024, (const bf16_t*)(ws + WB_MIN) + (size_t)16 * t * 1024, 1024, 1024, C.lane));
            constexpr int MR = TAIL_ON(4) ? NREAL : RPAD; pg8::Gemm g{H16, (const bf16_t*)(ws + WB_MIN), MR, 512, 1024}; pg8::StaticOrder S; S.init(MR, 512, C.G, (int)blockIdx.x);
            pg8::EpiStore E{(bf16_t*)(ws + M_CRAW), 512, 1.0f};
            pg8::gemm_phase<pg8::EpiStore, pg8::StaticOrder, true, true>(C.lds, g, S, E);
        }
        SEAMP(9);
        if (INP(10)) { PHASE_LOCALS
            const bf16_t* CR = (const bf16_t*)(ws + M_CRAW); bf16_t* CQ = (bf16_t*)(ws + M_CQ); bf16_t* CKV = (bf16_t*)(ws + M_CKV); bf16_t* KPb = (bf16_t*)(ws + M_KP);
            const int l = C.lane; const float* gp = l < 32 ? WP(11) + 8 * l : (l < 48 ? WP(13) + 8 * (l - 32) : WP(17) + 8 * ((l - 48) & 3));
            const f32x4 g0 = *(const f32x4*)gp, g1 = *(const f32x4*)(gp + 4);
#define P10_LOAD(mm) do { raw_n = *(const u32x4*)(CR + (size_t)(mm) * 512 + 8 * l); const int lr_ = (mm) < NREAL ? row_to_lrow(mm) : (mm) - NREAL; const float* rp_ = rope + (size_t)lr_ * 32 + 8 * (l & 1); \
                rc0_n = *(const f32x4*)rp_; rc1_n = *(const f32x4*)(rp_ + 4); rq0_n = *(const f32x4*)(rp_ + 16); rq1_n = *(const f32x4*)(rp_ + 20); } while (0)
            u32x4 raw_n = {0u, 0u, 0u, 0u}; f32x4 rc0_n = {0.f, 0.f, 0.f, 0.f}, rc1_n = rc0_n, rq0_n = rc0_n, rq1_n = rc0_n; if (C.gw < NROWS) P10_LOAD(C.gw);
            for (int m = C.gw; m < NROWS; m += C.NGW) {
                const u32x4 raw = raw_n; const f32x4 c0 = rc0_n, c1 = rc1_n, q0 = rq0_n, q1 = rq1_n; if (m + C.NGW < NROWS) P10_LOAD(m + C.NGW);
                float xv[8];
#pragma unroll
                for (int j = 0; j < 4; ++j) { xv[2 * j] = bf_lo(raw[j]); xv[2 * j + 1] = bf_hi(raw[j]); }
                float s0 = 0.f;
#pragma unroll
                for (int j = 0; j < 8; ++j) s0 += xv[j] * xv[j];
                const float s1 = s0 + __shfl_xor(s0, 1), s2 = s1 + __shfl_xor(s1, 2), s3 = s2 + __shfl_xor(s2, 4), s4 = s3 + __shfl_xor(s3, 8), s5 = s4 + __shfl_xor(s4, 16);
                const float rn = __builtin_amdgcn_rsqf(l < 32 ? s5 * (1.0f / 256.0f) + EPSN : (l < 48 ? s4 * (1.0f / 128.0f) + EPSN : s2 * (1.0f / 32.0f) + EPSN));
#pragma unroll
                for (int j = 0; j < 4; ++j) { xv[j] *= rn * g0[j]; xv[4 + j] *= rn * g1[j]; }
                float pt[8];
#pragma unroll
                for (int j = 0; j < 8; ++j) pt[j] = __shfl_xor(xv[j], 2);
                if (l >= 48 && l < 52) {
                    const float sgn = (l < 50) ? -1.0f : 1.0f;
#pragma unroll
                    for (int j = 0; j < 8; ++j) { const float c = j < 4 ? c0[j & 3] : c1[j & 3], s = j < 4 ? q0[j & 3] : q1[j & 3]; xv[j] = xv[j] * c + sgn * pt[j] * s; }
                }
                u32x4 o;
#pragma unroll
                for (int j = 0; j < 4; ++j) o[j] = cvt_pk_bf16(xv[2 * j], xv[2 * j + 1]);
                { bf16_t* dst = l < 32 ? CQ + (size_t)m * 256 + 8 * l : CKV + (size_t)m * 256 + 8 * (l - 32); const u32x4 ov = l < 48 ? o : (u32x4){0u, 0u, 0u, 0u}; *(u32x4*)dst = ov; }
                {
                    u32x4 ob;
#pragma unroll
                    for (int j = 0; j < 4; ++j) ob[j] = (unsigned)__shfl((int)o[j], 48 + (l & 3));
                    const bool meta = m >= NREAL; const int lrow0 = meta ? m - NREAL : row_to_lrow(m);
                    bf16_t* kd = KPb + (size_t)lrow0 * 1536 + (l >> 2) * 96 + 64 + 8 * (l & 3); *(u32x4*)kd = ob;
                    if (meta) for (int d = 1; d < NB; ++d) *(u32x4*)(kd + (size_t)d * LP * 1536) = ob; }
            }
#undef P10_LOAD
        }
        SEAMP(10);
        if (INP(11)) { PHASE_LOCALS
            constexpr int MR = TAIL_ON(5) ? NREAL : RPAD;
            if (TAIL_ON(5)) for (int t = tw; t < 96 + 128; t += C.NGW) {
                if (t < 96) *(u32x2*)((bf16_t*)(ws + M_QRAW) + (size_t)(NREAL + fr_) * 1536 + 16 * t + 4 * fq_) = pack4_bf16(tail_tile((const bf16_t*)(ws + M_CQ) + (size_t)NREAL * 256, 256, (const bf16_t*)(ws + WB_QUP) + (size_t)16 * t * 256, 256, 256, C.lane));
                else if (t < 96 + 64) { if (t < 96 + 16) { const int hh = t - 96; tail_khead<96>((const bf16_t*)(ws + M_CKV) + (size_t)NREAL * 256, 256, (const bf16_t*)(ws + WB_KVUP) + (size_t)((hh >> 2) * 256 + (hh & 3) * 32) * 256, 256, WP(16), (bf16_t*)(ws + M_KP), hh, C.lane); } }
                else { const int t2 = t - 96; const u32x2 w = pack4_bf16(tail_tile((const bf16_t*)(ws + M_CKV) + (size_t)NREAL * 256, 256, (const bf16_t*)(ws + WB_KVUP) + (size_t)16 * t2 * 256, 256, 256, C.lane)); const int col = 16 * t2 + 4 * fq_;
                    for (int b = 0; b < NB; ++b) *(u32x2*)((bf16_t*)(ws + M_VP) + (size_t)(b * LP + fr_) * 1024 + col - 1024) = w; } }
            { pg8::Gemm g{(const bf16_t*)(ws + M_CQ), (const bf16_t*)(ws + WB_QUP), MR, 1536, 256}; pg8::StaticOrder S; S.init(MR, 1536, C.G, (int)blockIdx.x);
              pg8::EpiStore E{(bf16_t*)(ws + M_QRAW), 1536, 1.0f};
              pg8::gemm_phase<pg8::EpiStore, pg8::StaticOrder, true, true>(C.lds, g, S, E); }
            __syncthreads(); asm volatile("" ::: "memory");
            { pg8::Gemm g{(const bf16_t*)(ws + M_CKV), (const bf16_t*)(ws + WB_KVUP), MR, 2048, 256}; pg8::StaticOrder S; S.init(MR, 2048, C.G, (int)blockIdx.x);
              pg8::EpiKvUp E{(bf16_t*)(ws + M_KP), WP(16), (bf16_t*)(ws + M_VP)};
              pg8::gemm_phase<pg8::EpiKvUp, pg8::StaticOrder, true, true>(C.lds, g, S, E); }
        }
        SEAMP(11);
        if (INP(13)) { PHASE_LOCALS
            const attn_body::AttnArgs AT{(const bf16_t*)(ws + M_QRAW), (const bf16_t*)(ws + M_KP), (const bf16_t*)(ws + M_VP), (bf16_t*)(ws + M_O), nullptr, WP(15), nullptr, rope};
            if (attn_body::attn_fixref_ok<1>(WP(15), WP(16), WP(17), C.lane)) attn_body::attn_phase<6, 1, 8, true>((char*)lds_raw, AT, (unsigned*)(ctl + CW_ATTQ + (2 * lp + 1) * 64));
            else attn_body::attn_phase<6, 1, 8, false>((char*)lds_raw, AT, (unsigned*)(ctl + CW_ATTQ + (2 * lp + 1) * 64));
        }
        SEAMP(13);
        if (INP(14)) { PHASE_LOCALS
            if (TAIL_ON(6)) for (int t = tw; t < 64; t += C.NGW) { const f32x4 a = tail_tile((const bf16_t*)(ws + M_O) + (size_t)NREAL * 1024, 1024, (const bf16_t*)(ws + WB_MOUT) + (size_t)16 * t * 1024, 1024, 1024, C.lane);
                const size_t off = (size_t)fr_ * 1024 + 16 * t + 4 * fq_; *(f32x4*)(hmeta + off) = *(const f32x4*)(hmeta + off) + a; }
            constexpr int MR = TAIL_ON(6) ? NREAL : RPAD; pg8::Gemm g{(const bf16_t*)(ws + M_O), (const bf16_t*)(ws + WB_MOUT), MR, 1024, 1024}; pg8::StaticOrder S; S.init(MR, 1024, C.G, (int)blockIdx.x);
            pg8::EpiResidT<false> E{H16, H16, nullptr, 1.0f, 0};
            pg8::gemm_phase<pg8::EpiResidT<false>, pg8::StaticOrder, true, true>(C.lds, g, S, E);
        }
        SEAMP(14);
        if (INP(15)) { PHASE_LOCALS
            constexpr int RB = 129;
            LAS int* lcnt = (LAS int*)C.lds; LAS int* lbase = lcnt + 8; LAS unsigned* lrec = (LAS unsigned*)(lbase + 8);
            if (C.tid < 8) lcnt[C.tid] = 0;
            __syncthreads();
            f32x4 gv[4]; load_gain(WP(19), gv, C.lane);
            float wr[16][8];
#pragma unroll
            for (int j = 0; j < 4; ++j)
#pragma unroll
                for (int i = 0; i < 4; ++i) { const float* p = WP(20) + (size_t)(4 * C.lane + 256 * j + i) * 8; const f32x4 a = *(const f32x4*)p, b = *(const f32x4*)(p + 4);
#pragma unroll
                    for (int e = 0; e < 4; ++e) { wr[4 * j + i][e] = a[e]; wr[4 * j + i][4 + e] = b[e]; } }
            const int rb = (C.G == 256 ? C.vcu : (int)blockIdx.x) * RB; const int nrows = rb >= NROWS ? 0 : (NROWS - rb < RB ? NROWS - rb : RB);
            f32x4 v[4] = {}; if (C.wave < nrows) LOAD_H(rb + C.wave, v);
            for (int ri = C.wave; ri < nrows; ri += NWAVES) { const int m = rb + ri; f32x4 nv[4] = {v[0], v[1], v[2], v[3]}; if (ri + NWAVES < nrows) LOAD_H(m + NWAVES, nv);
                if (f8moe) norm_row<true>(v, gv, (unsigned char*)XN + (size_t)m * 1024, C.lane); else norm_row(v, gv, XN + (size_t)m * 1024, C.lane);
                float lg[8];
#pragma unroll
                for (int e = 0; e < 8; ++e) { float s = 0.f;
#pragma unroll
                    for (int j = 0; j < 4; ++j) s += (v[j].x * wr[4 * j][e] + v[j].y * wr[4 * j + 1][e]) + (v[j].z * wr[4 * j + 2][e] + v[j].w * wr[4 * j + 3][e]);
                    lg[e] = wave_sum(s); }
                int e0 = 0; float l0 = lg[0];
#pragma unroll
                for (int e = 1; e < 8; ++e) if (lg[e] > l0) { l0 = lg[e]; e0 = e; }
                int e1 = -1; float l1 = -INFINITY;
#pragma unroll
                for (int e = 0; e < 8; ++e) if (e != e0 && lg[e] > l1) { l1 = lg[e]; e1 = e; }
                if (e1 < 0) e1 = (e0 + 1) & 7;
                const float w1 = 1.0f / (1.0f + expf(l0 - l1)), w0 = 1.0f - w1;
                if (C.lane == 0) { const int p0 = __hip_atomic_fetch_add(lcnt + e0, 1, __ATOMIC_RELAXED, __HIP_MEMORY_SCOPE_WORKGROUP), p1 = __hip_atomic_fetch_add(lcnt + e1, 1, __ATOMIC_RELAXED, __HIP_MEMORY_SCOPE_WORKGROUP);
                    LAS unsigned* r = lrec + ri * 6; r[0] = (unsigned)e0; r[1] = (unsigned)e1; r[2] = (unsigned)p0; r[3] = (unsigned)p1; r[4] = __float_as_uint(w0); r[5] = __float_as_uint(w1); }
#pragma unroll
                for (int j = 0; j < 4; ++j) v[j] = nv[j];
            }
            __syncthreads();
            if (C.tid < 8) lbase[C.tid] = (int)__hip_atomic_fetch_add(cnt + 64 * C.tid, (unsigned)lcnt[C.tid], RLX_AGENT);
            __syncthreads();
            for (int ri = C.tid; ri < nrows; ri += NTHREADS) { const LAS unsigned* r = lrec + ri * 6; unsigned* o = route + (size_t)(rb + ri) * 8;
                *(u32x4*)o = (u32x4){r[0], r[1], r[2] + (unsigned)lbase[r[0]], r[3] + (unsigned)lbase[r[1]]}; *(u32x2*)(o + 4) = (u32x2){r[4], r[5]}; }
        }
        SEAMP(15);
        if (INP(16)) { PHASE_LOCALS
            int roff[9]; moe_offsets(cnt, roff);
            bf16_t* XG = (bf16_t*)(ws + E_XG);
            const int rowb = f8moe ? 1024 : 2048;
            u32x4 ra_n = {0u, 0u, 0u, 0u}, a_n = ra_n, b_n = ra_n;
            if (C.gw < NROWS) { ra_n = *(const u32x4*)(route + (size_t)C.gw * 8); a_n = *(const u32x4*)((const unsigned char*)XN + (size_t)C.gw * rowb + 16 * C.lane); if (!f8moe) b_n = *(const u32x4*)((const unsigned char*)XN + (size_t)C.gw * rowb + 1024 + 16 * C.lane); }
            for (int m = C.gw; m < NROWS; m += C.NGW) { const u32x4 ra = ra_n, a = a_n, b = b_n; const int mn = m + C.NGW;
                if (mn < NROWS) { ra_n = *(const u32x4*)(route + (size_t)mn * 8); a_n = *(const u32x4*)((const unsigned char*)XN + (size_t)mn * rowb + 16 * C.lane); if (!f8moe) b_n = *(const u32x4*)((const unsigned char*)XN + (size_t)mn * rowb + 1024 + 16 * C.lane); }
                const int e0 = (int)ra.x, e1 = (int)ra.y; int d0 = 0, d1 = 0;
#pragma unroll
                for (int e = 0; e < 8; ++e) { d0 = e0 == e ? roff[e] : d0; d1 = e1 == e ? roff[e] : d1; }
                d0 = d0 * 256 + (int)ra.z; d1 = d1 * 256 + (int)ra.w;
                if (f8moe) { *(u32x4*)((unsigned char*)XG + (size_t)d0 * 1024 + 16 * C.lane) = a; *(u32x4*)((unsigned char*)XG + (size_t)d1 * 1024 + 16 * C.lane) = a; }
                else { *(u32x4*)((unsigned char*)XG + (size_t)d0 * 2048 + 16 * C.lane) = a; *(u32x4*)((unsigned char*)XG + (size_t)d0 * 2048 + 1024 + 16 * C.lane) = b;
                    *(u32x4*)((unsigned char*)XG + (size_t)d1 * 2048 + 16 * C.lane) = a; *(u32x4*)((unsigned char*)XG + (size_t)d1 * 2048 + 1024 + 16 * C.lane) = b; } }
        }
        SEAMP(16);
        if (INP(17)) { PHASE_LOCALS
            if (f8moe) { pg8::MoeOrder S; const int ntm = moe_offsets(cnt, S.toff); S.nM = ntm; S.nN = 22; S.nwg = ntm * 22; S.G = C.G; S.c = (int)blockIdx.x;
                pg8::Gemm g{(const bf16_t*)(ws + E_XG), (const bf16_t*)(ws + WB_MOEIN), ntm * 256, 5632, 512}; pg8::EpiSwiglu<true> E{ws + E_HF, nullptr, 1.0f / (F8_SX * F8_SW), 0};
                pg8::gemm_phase<pg8::EpiSwiglu<true>, pg8::MoeOrder, true, true, true>(C.lds, g, S, E); }
            else { pg8::MoeOrder S; const int ntm = moe_offsets(cnt, S.toff); S.nM = ntm; S.nN = 22; S.nwg = ntm * 22; S.G = C.G; S.c = (int)blockIdx.x;
                pg8::Gemm g{(const bf16_t*)(ws + E_XG), (const bf16_t*)(ws + WB_MOEIN), ntm * 256, 5632, 1024}; pg8::EpiSwiglu<false> E{ws + E_HF, nullptr, 1.0f, 0};
                pg8::gemm_phase<pg8::EpiSwiglu<false>, pg8::MoeOrder, true, true, false>(C.lds, g, S, E); }
        }
        SEAMP(17);
        if (INP(18)) { PHASE_LOCALS
            if (f8moe) { pg8::MoeOrder S; const int ntm = moe_offsets(cnt, S.toff); S.nM = ntm; S.nN = 4; S.nwg = ntm * 4; S.G = C.G; S.c = (int)blockIdx.x;
                pg8::Gemm g{(const bf16_t*)(ws + E_HF), (const bf16_t*)(ws + WB_MOEOUT), ntm * 256, 1024, DFF / 2}; pg8::EpiStore E{(bf16_t*)(ws + E_Y), 1024, 1.0f / (F8_SH * F8_SW)};
                pg8::gemm_phase<pg8::EpiStore, pg8::MoeOrder, true, true, true>(C.lds, g, S, E); }
            else { pg8::MoeOrder S; const int ntm = moe_offsets(cnt, S.toff); S.nM = ntm; S.nN = 4; S.nwg = ntm * 4; S.G = C.G; S.c = (int)blockIdx.x;
                pg8::Gemm g{(const bf16_t*)(ws + E_HF), (const bf16_t*)(ws + WB_MOEOUT), ntm * 256, 1024, DFF}; pg8::EpiStore E{(bf16_t*)(ws + E_Y), 1024, 1.0f};
                pg8::gemm_phase<pg8::EpiStore, pg8::MoeOrder, true, true, false>(C.lds, g, S, E); }
        }
        SEAMP(18);
    }
    if (PHEN(19) && IN(2 * NPH)) { const int lp = 1; PHASE_LOCALS
        int roff[9]; moe_offsets(cnt, roff);
#pragma unroll
        for (int e = 0; e < 9; ++e) roff[e] *= 256;
        { f32x4 v[4] = {}; u32x4 ra = {0u, 0u, 0u, 0u}; u32x2 rb = {0u, 0u}; int m = C.gw;
          if (m < NREAL) { load_row16(H16 + (size_t)m * 1024, v, C.lane); ra = *(const u32x4*)(route + (size_t)m * 8); rb = *(const u32x2*)(route + (size_t)m * 8 + 4); }
          for (; m < NREAL; m += C.NGW) { const int mn = m + C.NGW; f32x4 nv[4] = {v[0], v[1], v[2], v[3]}; u32x4 nra = {0u, 0u, 0u, 0u}; u32x2 nrb = {0u, 0u};
              if (mn < NREAL) { load_row16(H16 + (size_t)mn * 1024, nv, C.lane); nra = *(const u32x4*)(route + (size_t)mn * 8); nrb = *(const u32x2*)(route + (size_t)mn * 8 + 4); }
              moe_combine_row(v, ra, rb, roff, (const bf16_t*)(ws + E_Y), C.lane); store_row(hreal + (size_t)m * 1024, v, C.lane);
#pragma unroll
              for (int j = 0; j < 4; ++j) v[j] = nv[j];
              ra = nra; rb = nrb; } }
    }
#undef IN
#undef SEAM
#undef LOAD_H
#undef STORE_H
#undef WP
}

#ifndef MK_LAUNCH_PER_PHASE
#define MK_LAUNCH_PER_PHASE 0
#endif
extern "C" void kernel_launch(void* const* d_in, const int* in_sizes, int n_in, void* d_out, int out_size, void* d_ws, size_t ws_size, hipStream_t stream) {
    static int grid = 0;
    if (grid == 0) {
        if (n_in != 49 || in_sizes[0] != NREAL * 1024 || out_size != NREAL * 1024 || ws_size < WS_NEED) { fprintf(stderr, "kernel_launch: unexpected problem (n_in %d, in0 %d, out %d, ws %zu < %zu); nothing launched\n", n_in, n_in > 0 ? in_sizes[0] : -1, out_size, ws_size, (size_t)WS_NEED); grid = -1; return; }
        int dev = 0, cus = 0, per_cu = 0;
        if (hipGetDevice(&dev) != hipSuccess || hipDeviceGetAttribute(&cus, hipDeviceAttributeMultiprocessorCount, dev) != hipSuccess) { grid = -1; return; }
        if (hipFuncSetAttribute((const void*)trunk_fwd, hipFuncAttributeMaxDynamicSharedMemorySize, LDS_BYTES) != hipSuccess) { fprintf(stderr, "kernel_launch: hipFuncSetAttribute failed\n"); grid = -1; return; }
        if (hipOccupancyMaxActiveBlocksPerMultiprocessor(&per_cu, (const void*)trunk_fwd, NTHREADS, LDS_BYTES) != hipSuccess || per_cu < 1) { fprintf(stderr, "kernel_launch: occupancy query says %d blocks per CU\n", per_cu); }
        (void)hipGetLastError();
        grid = cus;
    }
    if (grid < 0) return;
    (void)hipMemsetAsync((char*)d_ws + WS_CTL, 0, CTL_ZERO_BYTES, stream);
    Args a{};
    for (int i = 0; i < 49; ++i) a.in[i] = (const float*)d_in[i];
    a.out = (float*)d_out; a.ws = (unsigned char*)d_ws;
#if MK_LAUNCH_PER_PHASE
    for (int p = 0; p < N_PHASES; ++p) { a.ph_lo = p; a.ph_hi = p + 1; hipLaunchKernelGGL(trunk_fwd, dim3(grid), dim3(NTHREADS), LDS_BYTES, stream, a); }
#else
    a.ph_lo = 0; a.ph_hi = N_PHASES;
    hipLaunchKernelGGL(trunk_fwd, dim3(grid), dim3(NTHREADS), LDS_BYTES, stream, a);
#endif
}
```
